# Optimizing an MI355X kernel written in HIP

```python
import math
import jax, jax.numpy as jnp
from jax import lax
import numpy as np

D_MODEL = 1024
BATCH = 8
SEQ = 2048
DEPTH = 2
DEC_BATCH = 128
DEC_SEQ = 4
PAST_LEN = 16384
PAGE_SIZE = 128

N_MIXERS = 2
N_RET = (DEPTH + 1) // 2
N_GDN = DEPTH // 2
RET_HEADS = 4
RET_DK = D_MODEL // RET_HEADS
RET_DV = 2 * RET_DK
RET_QK_DIM = RET_HEADS * RET_DK
RET_V_DIM = RET_HEADS * RET_DV
RET_IN = 2 * RET_QK_DIM + 2 * RET_V_DIM
RET_CHUNK = 64
ROPE_BASE = 10000.0
GDN_K_HEADS = D_MODEL // 128
GDN_V_HEADS = 2 * GDN_K_HEADS
GDN_DK = 128
GDN_DV = 128
GDN_KEY_DIM = GDN_K_HEADS * GDN_DK
GDN_VAL_DIM = GDN_V_HEADS * GDN_DV
GDN_CONV_DIM = 2 * GDN_KEY_DIM + GDN_VAL_DIM
GDN_CONV_W = 4
GDN_IN = GDN_CONV_DIM + GDN_VAL_DIM + 2 * GDN_V_HEADS
GDN_CHUNK = 64
D_FF = 2816
FFN_CONV_W = 3
EPS = 1e-6

kernel_name = 'hybrid_retention_gdn_convffn_adaln_step'


def ada_rmsnorm(x, g, shift, scale):
    xf = x.astype(jnp.float32)
    xn = xf * lax.rsqrt(jnp.mean(xf * xf, axis=-1, keepdims=True) + EPS) * g.astype(jnp.float32)
    return (xn * (1.0 + scale[:, None, :]) + shift[:, None, :]).astype(x.dtype)


def causal_dwconv(x, buf, w):
    W = w.shape[0]
    T = x.shape[1]
    xp = jnp.concatenate([buf.astype(x.dtype), x], axis=1)
    out = sum(xp[:, i:i + T, :] * w[i].astype(x.dtype) for i in range(W))
    return out, xp[:, T:, :]


def rope(x, pos0):
    T, d = x.shape[2], x.shape[3]
    half = d // 2
    inv_freq = ROPE_BASE ** (-jnp.arange(half, dtype=jnp.float32) / half)
    pos = pos0 + jnp.arange(T, dtype=jnp.float32)
    ang = pos[:, None] * inv_freq[None, :]
    cos, sin = jnp.cos(ang), jnp.sin(ang)
    x1, x2 = x[..., :half], x[..., half:]
    return jnp.concatenate([x1 * cos - x2 * sin, x1 * sin + x2 * cos], axis=-1)


def l2norm(x):
    return x * lax.rsqrt(jnp.sum(x * x, axis=-1, keepdims=True) + EPS)


def to_chunks(a, N, C):
    B, H = a.shape[0], a.shape[1]
    return jnp.moveaxis(a.reshape((B, H, N, C) + a.shape[3:]), 2, 0)


def from_chunks(o):
    N, B, H, C, d = o.shape
    return jnp.moveaxis(o, 0, 2).reshape(B, H, N * C, d)


def retention_chunked(q, k, v, s0):
    B, H, T, dk = q.shape
    C = math.gcd(T, RET_CHUNK)
    N = T // C
    log_gamma = jnp.log(1.0 - 2.0 ** (-5.0 - jnp.arange(H, dtype=jnp.float32)))
    idx = jnp.arange(C, dtype=jnp.float32)
    diff = idx[:, None] - idx[None, :]
    causal = diff >= 0
    decay = jnp.where(causal[None], jnp.exp(jnp.where(causal, diff, 0.0)[None] * log_gamma[:, None, None]), 0.0)
    q_decay = jnp.exp((idx + 1.0)[None, :] * log_gamma[:, None])[None, :, :, None]
    k_decay = jnp.exp((C - 1.0 - idx)[None, :] * log_gamma[:, None])[None, :, :, None]
    chunk_decay = jnp.exp(C * log_gamma)[None, :, None, None]

    def step(S, inp):
        qc, kc, vc = inp
        intra = jnp.einsum('bhid,bhjd->bhij', qc, kc) * decay[None]
        o = jnp.einsum('bhij,bhjv->bhiv', intra, vc) + jnp.einsum('bhid,bhdv->bhiv', qc, S) * q_decay
        S = S * chunk_decay + jnp.einsum('bhjd,bhjv->bhdv', kc * k_decay, vc)
        return S, o

    S, o = lax.scan(step, s0, (to_chunks(q, N, C), to_chunks(k, N, C), to_chunks(v, N, C)))
    return from_chunks(o), S


def retention_mixer(h, pos0, s0, w_in, w_out):
    B, T, _ = h.shape
    proj = jnp.einsum('btd,de->bte', h, w_in).astype(jnp.float32)
    q = proj[..., :RET_QK_DIM]
    k = proj[..., RET_QK_DIM:2 * RET_QK_DIM]
    v = proj[..., 2 * RET_QK_DIM:2 * RET_QK_DIM + RET_V_DIM]
    g = proj[..., 2 * RET_QK_DIM + RET_V_DIM:]
    heads = lambda a, d: a.reshape(B, T, RET_HEADS, d).transpose(0, 2, 1, 3)
    q = rope(heads(q, RET_DK), pos0)
    k = rope(heads(k, RET_DK), pos0) * RET_DK ** -0.5
    v = heads(v, RET_DV)
    o, S = retention_chunked(q, k, v, s0.astype(jnp.float32))
    o = o * lax.rsqrt(jnp.mean(o * o, axis=-1, keepdims=True) + EPS)
    o = o.transpose(0, 2, 1, 3).reshape(B, T, RET_V_DIM) * jax.nn.silu(g)
    return jnp.einsum('bte,ed->btd', o.astype(h.dtype), w_out), S


def gated_delta_chunked(q, k, v, g, beta, s0):
    B, H, T, dk = q.shape
    dv = v.shape[-1]
    C = math.gcd(T, GDN_CHUNK)
    N = T // C
    idx = jnp.arange(C)
    tri_incl = idx[:, None] >= idx[None, :]
    tri_strict = idx[:, None] > idx[None, :]
    eye = jnp.eye(C, dtype=jnp.float32)

    def step(S, inp):
        qc, kc, vc, gc, bc = inp
        G = jnp.cumsum(gc, axis=-1)
        dG = G[..., :, None] - G[..., None, :]
        decay = jnp.exp(jnp.where(tri_incl, dG, -jnp.inf))
        kb = kc * bc[..., None]
        L = jnp.where(tri_strict, jnp.einsum('bhid,bhjd->bhij', kb, kc) * decay, 0.0)
        rhs = jnp.concatenate([vc * bc[..., None], kb * jnp.exp(G)[..., None]], axis=-1)
        sol = lax.linalg.triangular_solve(eye + L, rhs, left_side=True, lower=True, unit_diagonal=True)
        u, w = sol[..., :dv], sol[..., dv:]
        v_new = u - jnp.einsum('bhid,bhdv->bhiv', w, S)
        attn = jnp.einsum('bhid,bhjd->bhij', qc, kc) * decay
        o = jnp.einsum('bhid,bhdv->bhiv', qc * jnp.exp(G)[..., None], S) + jnp.einsum('bhij,bhjv->bhiv', attn, v_new)
        G_last = G[..., -1]
        S = S * jnp.exp(G_last)[..., None, None] + jnp.einsum('bhjd,bhjv->bhdv', kc * jnp.exp(G_last[..., None] - G)[..., None], v_new)
        return S, o

    S, o = lax.scan(step, s0, (to_chunks(q, N, C), to_chunks(k, N, C), to_chunks(v, N, C),
                               to_chunks(g, N, C), to_chunks(beta, N, C)))
    return from_chunks(o), S


def gdn_mixer(h, conv_buf, s0, w_in, w_conv, a_log, dt_bias, norm_w, w_out):
    B, T, _ = h.shape
    proj = jnp.einsum('btd,de->bte', h, w_in)
    mixed = proj[..., :GDN_CONV_DIM]
    z = proj[..., GDN_CONV_DIM:GDN_CONV_DIM + GDN_VAL_DIM]
    b = proj[..., GDN_CONV_DIM + GDN_VAL_DIM:GDN_CONV_DIM + GDN_VAL_DIM + GDN_V_HEADS]
    a = proj[..., GDN_CONV_DIM + GDN_VAL_DIM + GDN_V_HEADS:]
    conv, new_buf = causal_dwconv(mixed, conv_buf, w_conv)
    conv = jax.nn.silu(conv.astype(jnp.float32))
    q = conv[..., :GDN_KEY_DIM].reshape(B, T, GDN_K_HEADS, GDN_DK)
    k = conv[..., GDN_KEY_DIM:2 * GDN_KEY_DIM].reshape(B, T, GDN_K_HEADS, GDN_DK)
    v = conv[..., 2 * GDN_KEY_DIM:].reshape(B, T, GDN_V_HEADS, GDN_DV)
    rep = GDN_V_HEADS // GDN_K_HEADS
    q = jnp.repeat(l2norm(q), rep, axis=2) * GDN_DK ** -0.5
    k = jnp.repeat(l2norm(k), rep, axis=2)
    beta = jax.nn.sigmoid(b.astype(jnp.float32))
    g = -jnp.exp(a_log.astype(jnp.float32)) * jax.nn.softplus(a.astype(jnp.float32) + dt_bias.astype(jnp.float32))
    o, S = gated_delta_chunked(q.transpose(0, 2, 1, 3), k.transpose(0, 2, 1, 3), v.transpose(0, 2, 1, 3),
                               g.transpose(0, 2, 1), beta.transpose(0, 2, 1), s0.astype(jnp.float32))
    o = o.transpose(0, 2, 1, 3)
    zf = z.astype(jnp.float32).reshape(B, T, GDN_V_HEADS, GDN_DV)
    o = o * lax.rsqrt(jnp.mean(o * o, axis=-1, keepdims=True) + EPS) * norm_w.astype(jnp.float32) * jax.nn.silu(zf)
    out = jnp.einsum('bte,ed->btd', o.reshape(B, T, GDN_VAL_DIM).astype(h.dtype), w_out)
    return out, S, new_buf


def conv_ffn(h, buf, w_up, w_dw, b_dw, w_down):
    up = jnp.einsum('btd,df->btf', h, w_up)
    gate_br, val = up[..., :D_FF], up[..., D_FF:]
    conv, new_buf = causal_dwconv(gate_br, buf, w_dw)
    act = jax.nn.silu(conv + b_dw.astype(conv.dtype)) * val
    return jnp.einsum('btf,fd->btd', act, w_down), new_buf


def trunk(x, c, pos0, s_ret, s_gdn, s_gconv, s_fconv, p):
    cs = jax.nn.silu(c.astype(jnp.float32))
    new_ret, new_gdn, new_gconv, new_fconv = [], [], [], []
    for l in range(DEPTH):
        mod = cs @ p['w_ada'][l].astype(jnp.float32) + p['b_ada'][l].astype(jnp.float32)
        sh1, sc1, g1, sh2, sc2, g2 = jnp.split(mod, 6, axis=-1)
        h = ada_rmsnorm(x, p['norm_mix'][l], sh1, sc1)
        i = l // N_MIXERS
        if l % N_MIXERS == 0:
            out, S = retention_mixer(h, pos0, s_ret[i], p['w_ret_in'][i], p['w_ret_out'][i])
            new_ret.append(S.astype(s_ret.dtype))
        else:
            out, S, buf = gdn_mixer(h, s_gconv[i], s_gdn[i], p['w_gdn_in'][i], p['w_gdn_conv'][i],
                                    p['gdn_a_log'][i], p['gdn_dt_bias'][i], p['gdn_norm'][i], p['w_gdn_out'][i])
            new_gdn.append(S.astype(s_gdn.dtype))
            new_gconv.append(buf.astype(s_gconv.dtype))
        x = (x.astype(jnp.float32) + g1[:, None, :] * out.astype(jnp.float32)).astype(x.dtype)
        h = ada_rmsnorm(x, p['norm_ffn'][l], sh2, sc2)
        out, buf = conv_ffn(h, s_fconv[l], p['w_ffn_up'][l], p['w_ffn_dw'][l], p['b_ffn_dw'][l], p['w_ffn_down'][l])
        new_fconv.append(buf.astype(s_fconv.dtype))
        x = (x.astype(jnp.float32) + g2[:, None, :] * out.astype(jnp.float32)).astype(x.dtype)
    mod = cs @ p['w_ada_final'].astype(jnp.float32) + p['b_ada_final'].astype(jnp.float32)
    shf, scf = jnp.split(mod, 2, axis=-1)
    y = ada_rmsnorm(x, p['norm_final'], shf, scf)
    return y, jnp.stack(new_ret), jnp.stack(new_gdn), jnp.stack(new_gconv), jnp.stack(new_fconv)


def setup_inputs(seed: int = 0) -> dict:
    key = jax.random.key(seed)
    ks = jax.random.split(key, 32)
    f32 = jnp.float32
    nrm = lambda k, shape, s: s * jax.random.normal(k, shape, f32)
    inp = {}
    inp['x_prompt'] = nrm(ks[0], (BATCH, SEQ, D_MODEL), 1.0)
    inp['x_sample'] = nrm(ks[1], (DEC_BATCH, DEC_SEQ, D_MODEL), 1.0)
    inp['state_ret'] = nrm(ks[2], (N_RET, DEC_BATCH, RET_HEADS, RET_DK, RET_DV), 0.1)
    inp['state_gdn'] = nrm(ks[3], (N_GDN, DEC_BATCH, GDN_V_HEADS, GDN_DK, GDN_DV), 0.1)
    inp['state_gdn_conv'] = nrm(ks[4], (N_GDN, DEC_BATCH, GDN_CONV_W - 1, GDN_CONV_DIM), 1.0)
    inp['state_ffn_conv'] = nrm(ks[5], (DEPTH, DEC_BATCH, FFN_CONV_W - 1, D_FF), 1.0)
    inp['c_prompt'] = nrm(ks[6], (BATCH, D_MODEL), 1.0)
    inp['c_sample'] = nrm(ks[7], (DEC_BATCH, D_MODEL), 1.0)
    inp['w_ada'] = nrm(ks[8], (DEPTH, D_MODEL, 6 * D_MODEL), 0.5 * D_MODEL ** -0.5)
    inp['b_ada'] = nrm(ks[9], (DEPTH, 6 * D_MODEL), 0.02)
    inp['w_ada_final'] = nrm(ks[10], (D_MODEL, 2 * D_MODEL), 0.5 * D_MODEL ** -0.5)
    inp['b_ada_final'] = nrm(ks[11], (2 * D_MODEL,), 0.02)
    inp['norm_mix'] = 1.0 + nrm(ks[12], (DEPTH, D_MODEL), 0.02)
    inp['norm_ffn'] = 1.0 + nrm(ks[13], (DEPTH, D_MODEL), 0.02)
    inp['norm_final'] = 1.0 + nrm(ks[14], (D_MODEL,), 0.02)
    inp['w_ret_in'] = nrm(ks[15], (N_RET, D_MODEL, RET_IN), D_MODEL ** -0.5)
    inp['w_ret_out'] = nrm(ks[16], (N_RET, RET_V_DIM, D_MODEL), RET_V_DIM ** -0.5)
    inp['w_gdn_in'] = nrm(ks[17], (N_GDN, D_MODEL, GDN_IN), D_MODEL ** -0.5)
    inp['w_gdn_conv'] = nrm(ks[18], (N_GDN, GDN_CONV_W, GDN_CONV_DIM), GDN_CONV_W ** -0.5)
    inp['gdn_a_log'] = jnp.log(jax.random.uniform(ks[19], (N_GDN, GDN_V_HEADS), f32, 1.0, 16.0))
    dt = jnp.exp(jax.random.uniform(ks[20], (N_GDN, GDN_V_HEADS), f32, math.log(1e-3), math.log(1e-1)))
    inp['gdn_dt_bias'] = dt + jnp.log(-jnp.expm1(-dt))
    inp['gdn_norm'] = 1.0 + nrm(ks[21], (N_GDN, GDN_DV), 0.02)
    inp['w_gdn_out'] = nrm(ks[22], (N_GDN, GDN_VAL_DIM, D_MODEL), GDN_VAL_DIM ** -0.5)
    inp['w_ffn_up'] = nrm(ks[23], (DEPTH, D_MODEL, 2 * D_FF), D_MODEL ** -0.5)
    inp['w_ffn_dw'] = nrm(ks[24], (DEPTH, FFN_CONV_W, D_FF), FFN_CONV_W ** -0.5)
    inp['b_ffn_dw'] = nrm(ks[25], (DEPTH, D_FF), 0.02)
    inp['w_ffn_down'] = nrm(ks[26], (DEPTH, D_FF, D_MODEL), D_FF ** -0.5)
    return inp


def reference(x_prompt, x_sample, state_ret, state_gdn, state_gdn_conv, state_ffn_conv,
              c_prompt, c_sample, w_ada, b_ada, w_ada_final, b_ada_final,
              norm_mix, norm_ffn, norm_final, w_ret_in, w_ret_out,
              w_gdn_in, w_gdn_conv, gdn_a_log, gdn_dt_bias, gdn_norm, w_gdn_out,
              w_ffn_up, w_ffn_dw, b_ffn_dw, w_ffn_down):
    p = {'w_ada': w_ada, 'b_ada': b_ada, 'w_ada_final': w_ada_final, 'b_ada_final': b_ada_final,
         'norm_mix': norm_mix, 'norm_ffn': norm_ffn, 'norm_final': norm_final,
         'w_ret_in': w_ret_in, 'w_ret_out': w_ret_out,
         'w_gdn_in': w_gdn_in, 'w_gdn_conv': w_gdn_conv, 'gdn_a_log': gdn_a_log,
         'gdn_dt_bias': gdn_dt_bias, 'gdn_norm': gdn_norm, 'w_gdn_out': w_gdn_out,
         'w_ffn_up': w_ffn_up, 'w_ffn_dw': w_ffn_dw, 'b_ffn_dw': b_ffn_dw, 'w_ffn_down': w_ffn_down}
    z_ret = jnp.zeros((N_RET, BATCH, RET_HEADS, RET_DK, RET_DV), state_ret.dtype)
    z_gdn = jnp.zeros((N_GDN, BATCH, GDN_V_HEADS, GDN_DK, GDN_DV), state_gdn.dtype)
    z_gconv = jnp.zeros((N_GDN, BATCH, GDN_CONV_W - 1, GDN_CONV_DIM), state_gdn_conv.dtype)
    z_fconv = jnp.zeros((DEPTH, BATCH, FFN_CONV_W - 1, D_FF), state_ffn_conv.dtype)
    y_prompt, ret_p, gdn_p, gconv_p, fconv_p = trunk(x_prompt, c_prompt, 0, z_ret, z_gdn, z_gconv, z_fconv, p)
    y_sample, ret_s, gdn_s, gconv_s, fconv_s = trunk(x_sample, c_sample, PAST_LEN, state_ret, state_gdn,
                                                     state_gdn_conv, state_ffn_conv, p)
    return (y_prompt, y_sample, ret_p, gdn_p, gconv_p, fconv_p, ret_s, gdn_s, gconv_s, fconv_s)
```

```cpp
#include <hip/hip_runtime.h>
#include <hip/hip_cooperative_groups.h>
#include <cstdio>
namespace cg = cooperative_groups;
namespace pg8 {
#define PG8_LAS __attribute__((address_space(3)))
typedef unsigned short bf16_t;
typedef short bf16x8 __attribute__((ext_vector_type(8)));
typedef float f32x4 __attribute__((ext_vector_type(4)));
typedef unsigned u32x4 __attribute__((ext_vector_type(4)));
constexpr int BM = 256, BK = 64, HALF = 128, HTB = HALF * BK * 2  , STAGE_BYTES = 8 * HTB, NXCD = 8, WGM = 8;

__host__ __device__ __forceinline__ int lds_byte(int r, int c) { const int st = (r >> 4) * 2 + (c >> 5), rr = r & 15, cc = c & 31, ob = rr * 64 + cc * 2; return st * 1024 + (ob ^ (((ob >> 9) & 1) << 5)); }
__host__ __device__ __forceinline__ void stage_rc(int b, int& R, int& C) { const int st = b / 1024, sb = b % 1024, swz = sb ^ (((sb >> 9) & 1) << 5); R = (st >> 1) * 16 + swz / 64; C = (st & 1) * 32 + (swz % 64) / 2; }
__host__ __device__ __forceinline__ int perm32(int rho) { const int n = rho >> 4, i = rho & 15; return 8 * (i >> 2) + 4 * n + (i & 3); }

struct Unit { int pm, pn; };
struct Gemm { const bf16_t* A; const bf16_t* Bt; int M, N, K; };

struct StaticOrder {
    int nM, nN, nwg, G, c;
    __host__ __device__ void init(int M, int N, int G_, int c_) { nM = M / BM; nN = N / BM; nwg = nM * nN; G = G_; c = c_; }
    __host__ __device__ bool next(int i, Unit& u) const {
        const long L = (long)i * G + c; if (L >= nwg) return false;
        int wgid = (int)L; { const int q = nwg / NXCD, r = nwg % NXCD, xcd = wgid % NXCD, off = wgid / NXCD; wgid = (xcd < r ? xcd * (q + 1) : r * (q + 1) + (xcd - r) * q) + off; }
        const int nig = WGM * nN, gid = wgid / nig, fm = gid * WGM, gsz = (nM - fm) < WGM ? (nM - fm) : WGM;
        u.pm = fm + ((wgid % nig) % gsz); u.pn = (wgid % nig) / gsz; return true;
    }
    __device__ __forceinline__ void a_ready(const Unit&) const {}
    __device__ __forceinline__ void done(const Unit&) const {}
};
struct CountedOrder : StaticOrder {
    const unsigned* ready; unsigned need; unsigned* tmo;
    __device__ __forceinline__ void a_ready(const Unit& u) const {
        if (threadIdx.x < 64) {
            const unsigned long long t0 = __builtin_amdgcn_s_memrealtime(); unsigned polls = 0;
            while ((unsigned)__builtin_amdgcn_readfirstlane(__hip_atomic_load(ready + 64 * u.pm, __ATOMIC_RELAXED, __HIP_MEMORY_SCOPE_AGENT)) < need) {
                if ((++polls & 255u) == 0u && __builtin_amdgcn_readfirstlane(__hip_atomic_load(tmo, __ATOMIC_RELAXED, __HIP_MEMORY_SCOPE_AGENT)) != 0u) break;
                if (__builtin_amdgcn_s_memrealtime() - t0 > 2000000ull) {
                    if (threadIdx.x == 0) { unsigned expect = 0u; __hip_atomic_compare_exchange_strong(tmo + 1, &expect, 0x600u | (unsigned)(u.pm & 0xff), __ATOMIC_RELAXED, __ATOMIC_RELAXED, __HIP_MEMORY_SCOPE_AGENT); __hip_atomic_store(tmo, 1u, __ATOMIC_RELAXED, __HIP_MEMORY_SCOPE_AGENT); }
                    break; }
                __builtin_amdgcn_s_sleep(2); }
            __builtin_amdgcn_fence(__ATOMIC_ACQUIRE, "agent");
            asm volatile("s_waitcnt vmcnt(0)" ::: "memory");
        }
#if !defined(BROKEN_HOOK_NO_BARRIER)
        asm volatile("" ::: "memory"); __builtin_amdgcn_s_barrier(); asm volatile("" ::: "memory");
#endif
    }
};

__device__ __forceinline__ unsigned cvt_pk_bf16(float lo, float hi) { unsigned r; asm volatile("v_cvt_pk_bf16_f32 %0, %1, %2" : "=v"(r) : "v"(lo), "v"(hi)); return r; }
typedef float f32x2 __attribute__((ext_vector_type(2)));
__device__ __forceinline__ f32x2 gelu_pk(f32x2 v) {
    const f32x2 av = __builtin_elementwise_abs(v), d = av * 0.2316418882f + 1.0f;
    f32x2 t; t.x = __builtin_amdgcn_rcpf(d.x); t.y = __builtin_amdgcn_rcpf(d.y);
    f32x2 q = t * 0.5307027145f + (-0.7265760135f); q = q * t + 0.7107068705f; q = q * t + (-0.142248368f); q = q * t + 0.127414796f; q = q * t;
    const f32x2 s = (v * v) * (-0.72134752044f);
    f32x2 e; e.x = __builtin_amdgcn_exp2f(s.x); e.y = __builtin_amdgcn_exp2f(s.y);
    const f32x2 m = v * (q * e), r = v - m;
    f32x2 o; o.x = v.x < 0.f ? m.x : r.x; o.y = v.y < 0.f ? m.y : r.y; return o;
}

struct EpiF32 {
    static constexpr bool PERM = false, AFTER_DRAIN = false;
    float* C; int ldc; const float* bias;
    __device__ __forceinline__ void operator()(const f32x4 (&acc)[2][2][4][2], const Unit& u, int wr, int wc, int fr, int fq) const {
        const int row0 = u.pm * BM + wr * 64 + fr, col0 = u.pn * BM + wc * 32 + 4 * fq;
        f32x4 bv[2][2];
#pragma unroll
        for (int bj = 0; bj < 2; ++bj)
#pragma unroll
            for (int n = 0; n < 2; ++n) bv[bj][n] = bias ? *(const f32x4*)(bias + col0 + bj * HALF + n * 16) : (f32x4){0.f, 0.f, 0.f, 0.f};
#pragma unroll
        for (int ai = 0; ai < 2; ++ai)
#pragma unroll
            for (int m = 0; m < 4; ++m) { float* rowp = C + (size_t)(row0 + ai * HALF + m * 16) * ldc + col0;
#pragma unroll
                for (int bj = 0; bj < 2; ++bj)
#pragma unroll
                    for (int n = 0; n < 2; ++n) *(f32x4*)(rowp + bj * HALF + n * 16) = acc[ai][bj][m][n] + bv[bj][n]; }
    }
};
template <int ACT  > struct EpiBf16 {
    static constexpr bool PERM = true, AFTER_DRAIN = false;
    bf16_t* O; int ldc; const float* bias; int split_cols; size_t split_stride;
    __device__ __forceinline__ void operator()(const f32x4 (&acc)[2][2][4][2], const Unit& u, int wr, int wc, int fr, int fq) const {
        const int row0 = u.pm * BM + wr * 64 + fr; int colt = u.pn * BM; bf16_t* base = O;
        if (split_cols) { const int t = colt / split_cols; base += (size_t)t * split_stride; colt -= t * split_cols; }
        const int col0 = colt + wc * 32 + 8 * fq, bcol0 = u.pn * BM + wc * 32 + 8 * fq;
        f32x4 bv[2][2];
#pragma unroll
        for (int bj = 0; bj < 2; ++bj)
#pragma unroll
            for (int n = 0; n < 2; ++n) bv[bj][n] = bias ? *(const f32x4*)(bias + bcol0 + bj * HALF + 4 * n) : (f32x4){0.f, 0.f, 0.f, 0.f};
#pragma unroll
        for (int ai = 0; ai < 2; ++ai)
#pragma unroll
            for (int m = 0; m < 4; ++m) { bf16_t* rowp = base + (size_t)(row0 + ai * HALF + m * 16) * ldc + col0;
#pragma unroll
                for (int bj = 0; bj < 2; ++bj) { f32x4 v0 = acc[ai][bj][m][0] + bv[bj][0], v1 = acc[ai][bj][m][1] + bv[bj][1];
                    if (ACT == 1) { f32x2 a = gelu_pk((f32x2){v0[0], v0[1]}), b = gelu_pk((f32x2){v0[2], v0[3]}), c = gelu_pk((f32x2){v1[0], v1[1]}), d = gelu_pk((f32x2){v1[2], v1[3]});
                        v0 = (f32x4){a.x, a.y, b.x, b.y}; v1 = (f32x4){c.x, c.y, d.x, d.y}; }
                    if (ACT == 2) {
#pragma unroll
                        for (int j = 0; j < 4; ++j) { v0[j] = 0.5f * v0[j] * (1.0f + erff(v0[j] * 0.70710678f)); v1[j] = 0.5f * v1[j] * (1.0f + erff(v1[j] * 0.70710678f)); } }
                    u32x4 w; w.x = cvt_pk_bf16(v0[0], v0[1]); w.y = cvt_pk_bf16(v0[2], v0[3]); w.z = cvt_pk_bf16(v1[0], v1[1]); w.w = cvt_pk_bf16(v1[2], v1[3]);
                    *(u32x4*)(rowp + bj * HALF) = w; } }
    }
};

struct PanelStats {
    unsigned* xbuf;
    unsigned* cnt;
    unsigned* tmo;
    int ntn; float eps;
    unsigned code;
    __device__ __forceinline__ bool run(const f32x4 (&v)[2][2][4][2], const Unit& u, int wr, int wc, int fr, int fq, PG8_LAS unsigned char* lds, int wid, int lane) const {
        typedef float f32x2v __attribute__((ext_vector_type(2)));
        PG8_LAS f32x2v* P = (PG8_LAS f32x2v*)lds;
        PG8_LAS f32x2v* S = (PG8_LAS f32x2v*)(lds + 8192);
        PG8_LAS unsigned* flag = (PG8_LAS unsigned*)(lds + 8192 + 2048);
#pragma unroll
        for (int ai = 0; ai < 2; ++ai)
#pragma unroll
            for (int m = 0; m < 4; ++m) {
                float s = 0.f;
#pragma unroll
                for (int bj = 0; bj < 2; ++bj)
#pragma unroll
                    for (int n = 0; n < 2; ++n) { const f32x4 x = v[ai][bj][m][n]; s += (x[0] + x[1]) + (x[2] + x[3]); }
                s += __shfl_xor(s, 16); s += __shfl_xor(s, 32);
                const float mw = s * (1.0f / 64.0f); float q = 0.f;
#pragma unroll
                for (int bj = 0; bj < 2; ++bj)
#pragma unroll
                    for (int n = 0; n < 2; ++n) { const f32x4 d = v[ai][bj][m][n] - mw; q += (d[0] * d[0] + d[1] * d[1]) + (d[2] * d[2] + d[3] * d[3]); }
                q += __shfl_xor(q, 16); q += __shfl_xor(q, 32);
                if (fq == 0) P[(ai * HALF + wr * 64 + m * 16 + fr) * 4 + wc] = (f32x2v){mw, q};
            }
        asm volatile("s_waitcnt lgkmcnt(0)" ::: "memory"); __builtin_amdgcn_s_barrier(); asm volatile("" ::: "memory");
#if defined(BROKEN_NO_WAIT)
        if (blockIdx.x >= 64) { const long long t0 = clock64(); while (clock64() - t0 < 60000) __builtin_amdgcn_s_sleep(8); }
#endif
        const int row = wid * 32 + (lane & 31);
        if (lane < 32) {
            const f32x2v a = P[row * 4 + 0], b = P[row * 4 + 1], c = P[row * 4 + 2], d = P[row * 4 + 3];
            const float mt = (a.x + b.x + c.x + d.x) * 0.25f;
            const float da = a.x - mt, db = b.x - mt, dc = c.x - mt, dd = d.x - mt;
            const float m2 = (a.y + b.y) + (c.y + d.y) + 64.0f * ((da * da + db * db) + (dc * dc + dd * dd));
            unsigned long long* slot = (unsigned long long*)xbuf + ((size_t)(u.pm * BM + row) * 4 + u.pn);
            __hip_atomic_store(slot, ((unsigned long long)__float_as_uint(m2) << 32) | __float_as_uint(mt), __ATOMIC_RELAXED, __HIP_MEMORY_SCOPE_AGENT);
        }
        asm volatile("s_waitcnt vmcnt(0)" ::: "memory");
        if (lane == 0) __hip_atomic_fetch_add(cnt + 64 * u.pm, 1u, __ATOMIC_RELAXED, __HIP_MEMORY_SCOPE_AGENT);
        if (wid == 0) {
            bool dead = false; const unsigned long long t0 = __builtin_amdgcn_s_memrealtime(); const unsigned want = 8u * (unsigned)ntn;
            for (;;) {
#if defined(BROKEN_NO_WAIT)
                break;
#endif
                if ((unsigned)__builtin_amdgcn_readfirstlane(__hip_atomic_load(cnt + 64 * u.pm, __ATOMIC_RELAXED, __HIP_MEMORY_SCOPE_AGENT)) >= want) break;
                if (__builtin_amdgcn_s_memrealtime() - t0 > 2000000ull) {
                    if (lane == 0) { unsigned expect = 0u; __hip_atomic_compare_exchange_strong(tmo + 1, &expect, code | (unsigned)(u.pm & 0xff), __ATOMIC_RELAXED, __ATOMIC_RELAXED, __HIP_MEMORY_SCOPE_AGENT);
                                     __hip_atomic_store(tmo, 1u, __ATOMIC_RELAXED, __HIP_MEMORY_SCOPE_AGENT); }
                    dead = true; break; }
                __builtin_amdgcn_s_sleep(2);
            }
            __builtin_amdgcn_fence(__ATOMIC_ACQUIRE, "agent");
            if (lane == 0) flag[0] = dead ? 1u : 0u;
        }
        asm volatile("s_waitcnt vmcnt(0) lgkmcnt(0)" ::: "memory"); __builtin_amdgcn_s_barrier(); asm volatile("" ::: "memory");
        const bool bad = flag[0] != 0u;
        if (lane < 32) {
            const unsigned long long* slot = (const unsigned long long*)xbuf + (size_t)(u.pm * BM + row) * 4; float mt[4], m2[4]; float ms = 0.f;
#pragma unroll
            for (int t = 0; t < 4; ++t) { if (t < ntn) { const unsigned long long w = __hip_atomic_load(slot + t, __ATOMIC_RELAXED, __HIP_MEMORY_SCOPE_AGENT); mt[t] = __uint_as_float((unsigned)w); m2[t] = __uint_as_float((unsigned)(w >> 32)); } else { mt[t] = 0.f; m2[t] = 0.f; } ms += mt[t]; }
            const float mean = ms / (float)ntn; float q = 0.f;
#pragma unroll
            for (int t = 0; t < 4; ++t) if (t < ntn) { const float dm = mt[t] - mean; q += m2[t] + 256.0f * dm * dm; }
            S[row] = (f32x2v){mean, 1.0f / sqrtf(q / (256.0f * (float)ntn) + eps)};
        }
        asm volatile("s_waitcnt lgkmcnt(0)" ::: "memory"); __builtin_amdgcn_s_barrier(); asm volatile("" ::: "memory");
        return bad;
    }
};
struct EpiLnRes {
    static constexpr bool PERM = false, AFTER_DRAIN = true;
    const float* base; float* out; int ldc; const float* bias; PanelStats st; unsigned poison;
    __device__ __forceinline__ void refuse(size_t i0, size_t stride, int M, int N) const { const float q = __builtin_nanf(""); for (size_t i = i0; i < (size_t)M * N; i += stride) out[(i / N) * ldc + i % N] = q;
        if (i0 == 0) { unsigned expect = 0u; __hip_atomic_compare_exchange_strong(st.tmo + 1, &expect, 0x7f0u, __ATOMIC_RELAXED, __ATOMIC_RELAXED, __HIP_MEMORY_SCOPE_AGENT); __hip_atomic_store(st.tmo, 1u, __ATOMIC_RELAXED, __HIP_MEMORY_SCOPE_AGENT); } }
    __device__ __forceinline__ void fused(f32x4 (&acc)[2][2][4][2], const Unit& u, int wr, int wc, int fr, int fq, PG8_LAS unsigned char* lds, int wid, int lane) const {
        typedef float f32x2v __attribute__((ext_vector_type(2)));
        const PG8_LAS f32x2v* S = (const PG8_LAS f32x2v*)(lds + 8192);
        const int col0 = u.pn * BM + wc * 32 + 4 * fq;
#pragma unroll
        for (int bj = 0; bj < 2; ++bj)
#pragma unroll
            for (int n = 0; n < 2; ++n) { const f32x4 bv = bias ? *(const f32x4*)(bias + col0 + bj * HALF + n * 16) : (f32x4){0.f, 0.f, 0.f, 0.f};
#pragma unroll
                for (int ai = 0; ai < 2; ++ai)
#pragma unroll
                    for (int m = 0; m < 4; ++m) acc[ai][bj][m][n] += bv; }
        const bool bad = st.run(acc, u, wr, wc, fr, fq, lds, wid, lane) || poison != 0u;
        const float qnan = __builtin_nanf("");
#pragma unroll
        for (int ai = 0; ai < 2; ++ai)
#pragma unroll
            for (int m = 0; m < 4; ++m) { const int r = ai * HALF + wr * 64 + m * 16 + fr; const f32x2v sr = S[r]; const size_t off = (size_t)(u.pm * BM + r) * ldc + col0;
#pragma unroll
                for (int bj = 0; bj < 2; ++bj)
#pragma unroll
                    for (int n = 0; n < 2; ++n) { const f32x4 bs = *(const f32x4*)(base + off + bj * HALF + n * 16); f32x4 o = bs + (acc[ai][bj][m][n] - sr.x) * sr.y;
                        if (bad) o = (f32x4){qnan, qnan, qnan, qnan}; *(f32x4*)(out + off + bj * HALF + n * 16) = o; }
                asm volatile("" ::: "memory"); }
    }
};
struct EpiLnResLn {
    static constexpr bool PERM = false, AFTER_DRAIN = true;
    const float* base; float* out; bf16_t* xn; int ldc; const float* bias; PanelStats st1, st2; unsigned poison;
    __device__ __forceinline__ void refuse(size_t i0, size_t stride, int M, int N) const { const float q = __builtin_nanf(""); for (size_t i = i0; i < (size_t)M * N; i += stride) { const size_t o = (i / N) * ldc + i % N; out[o] = q; xn[o] = (bf16_t)0x7fc0u; }
        if (i0 == 0) { unsigned expect = 0u; __hip_atomic_compare_exchange_strong(st1.tmo + 1, &expect, 0x7f0u, __ATOMIC_RELAXED, __ATOMIC_RELAXED, __HIP_MEMORY_SCOPE_AGENT); __hip_atomic_store(st1.tmo, 1u, __ATOMIC_RELAXED, __HIP_MEMORY_SCOPE_AGENT); } }
    __device__ __forceinline__ void fused(f32x4 (&acc)[2][2][4][2], const Unit& u, int wr, int wc, int fr, int fq, PG8_LAS unsigned char* lds, int wid, int lane) const {
        typedef float f32x2v __attribute__((ext_vector_type(2))); typedef unsigned u32x2v __attribute__((ext_vector_type(2)));
        const PG8_LAS f32x2v* S = (const PG8_LAS f32x2v*)(lds + 8192);
        const int col0 = u.pn * BM + wc * 32 + 4 * fq;
#pragma unroll
        for (int bj = 0; bj < 2; ++bj)
#pragma unroll
            for (int n = 0; n < 2; ++n) { const f32x4 bv = bias ? *(const f32x4*)(bias + col0 + bj * HALF + n * 16) : (f32x4){0.f, 0.f, 0.f, 0.f};
#pragma unroll
                for (int ai = 0; ai < 2; ++ai)
#pragma unroll
                    for (int m = 0; m < 4; ++m) acc[ai][bj][m][n] += bv; }
        bool bad = st1.run(acc, u, wr, wc, fr, fq, lds, wid, lane) || poison != 0u;
        const float qnan = __builtin_nanf("");
#pragma unroll
        for (int ai = 0; ai < 2; ++ai)
#pragma unroll
            for (int m = 0; m < 4; ++m) { const int r = ai * HALF + wr * 64 + m * 16 + fr; const f32x2v sr = S[r]; const size_t off = (size_t)(u.pm * BM + r) * ldc + col0;
#pragma unroll
                for (int bj = 0; bj < 2; ++bj)
#pragma unroll
                    for (int n = 0; n < 2; ++n) { const f32x4 bs = *(const f32x4*)(base + off + bj * HALF + n * 16); acc[ai][bj][m][n] = bs + (acc[ai][bj][m][n] - sr.x) * sr.y; }
                asm volatile("" : "+v"(acc[ai][0][m][0]), "+v"(acc[ai][0][m][1]), "+v"(acc[ai][1][m][0]), "+v"(acc[ai][1][m][1]));
                if (m & 1) asm volatile("" ::: "memory"); }
        const bool bad1 = bad;
        bad = st2.run(acc, u, wr, wc, fr, fq, lds, wid, lane) || bad;
#pragma unroll
        for (int ai = 0; ai < 2; ++ai)
#pragma unroll
            for (int m = 0; m < 4; ++m) { const int r = ai * HALF + wr * 64 + m * 16 + fr; const f32x2v sr = S[r]; const size_t off = (size_t)(u.pm * BM + r) * ldc + col0;
#pragma unroll
                for (int bj = 0; bj < 2; ++bj)
#pragma unroll
                    for (int n = 0; n < 2; ++n) { const f32x4 x1 = acc[ai][bj][m][n]; *(f32x4*)(out + off + bj * HALF + n * 16) = bad1 ? (f32x4){qnan, qnan, qnan, qnan} : x1;
                        const f32x4 o = (x1 - sr.x) * sr.y; u32x2v w; w.x = cvt_pk_bf16(o[0], o[1]); w.y = cvt_pk_bf16(o[2], o[3]);
                        if (bad) { w.x = 0x7fc07fc0u; w.y = 0x7fc07fc0u; } *(u32x2v*)(xn + off + bj * HALF + n * 16) = w; }
                asm volatile("" ::: "memory"); }
    }
};

template <class Epi, class Sched, bool STAMP = false>
__device__ __forceinline__ void gemm_phase(PG8_LAS unsigned char* lds, const Gemm g, const Sched& S, const Epi& E, unsigned long long* stamps) {
    const int tid = threadIdx.x, wid = __builtin_amdgcn_readfirstlane(tid >> 6), lane = tid & 63, wr = wid >> 2, wc = wid & 3, fr = lane & 15, fq = lane >> 4;
    const int K = g.K, nt = K / BK;
    int ts_lo = 0, ts_hi = 0, nts = 0; const unsigned long long rt_entry = STAMP ? (unsigned long long)wall_clock64() : 0ull;
#define PG8_STAMP() do { if (STAMP && wid == 0 && nts < 64) { const unsigned long long _c = (unsigned long long)clock64(); \
        ts_lo = (lane == nts) ? (int)(unsigned)_c : ts_lo; ts_hi = (lane == nts) ? (int)(unsigned)(_c >> 32) : ts_hi; ++nts; } } while (0)
    PG8_STAMP();
    unsigned voffA[2], voffB[2];
#pragma unroll
    for (int i = 0; i < 2; ++i) { int R, C; stage_rc(tid * 16 + i * 8192, R, C); const int Rb = Epi::PERM ? ((R & ~31) + perm32(R & 31)) : R;
        voffA[i] = (unsigned)(R * K + C) * 2u; voffB[i] = (unsigned)(Rb * K + C) * 2u; }
    const size_t kstep = (size_t)(BK * 2);
    const size_t hstep = (size_t)HALF * K * 2;
    const size_t tstep = 2 * hstep;
    const unsigned ldsw = (unsigned)wid * 1024u;
    const int aoff = lds_byte(wr * 64 + fr, fq * 8), boff = lds_byte(wc * 32 + fr, fq * 8);
#define PG8_SA(b, h) (((b) * 2 + (h)) * HTB)
#define PG8_SB(b, h) ((4 + (b) * 2 + (h)) * HTB)
#define PG8_STAGE(bufoff, gbase, voff) do { _Pragma("unroll") for (int _i = 0; _i < 2; ++_i) \
        __builtin_amdgcn_global_load_lds((const unsigned*)((const char*)(gbase) + (voff)[_i]), (PG8_LAS unsigned*)(lds + (bufoff) + ldsw + _i * 8192), 16, 0, 0); } while (0)
#define PG8_LDA(dst, b, h) do { _Pragma("unroll") for (int m = 0; m < 4; ++m) _Pragma("unroll") for (int k = 0; k < 2; ++k) dst[m][k] = *(const PG8_LAS bf16x8*)(lds + PG8_SA(b, h) + aoff + m * 2048 + k * 1024); } while (0)
#define PG8_LDB(dst, b, h) do { _Pragma("unroll") for (int n = 0; n < 2; ++n) _Pragma("unroll") for (int k = 0; k < 2; ++k) dst[n][k] = *(const PG8_LAS bf16x8*)(lds + PG8_SB(b, h) + boff + n * 2048 + k * 1024); } while (0)
#define PG8_MMA(ai, bj, At, Bt) do { __builtin_amdgcn_s_setprio(1); _Pragma("unroll") for (int m = 0; m < 4; ++m) _Pragma("unroll") for (int n = 0; n < 2; ++n) _Pragma("unroll") for (int k = 0; k < 2; ++k) \
        acc[ai][bj][m][n] = __builtin_amdgcn_mfma_f32_16x16x32_bf16(Bt[n][k], At[m][k], acc[ai][bj][m][n], 0, 0, 0); __builtin_amdgcn_s_setprio(0); } while (0)
#define PG8_WAIT_V(n) asm volatile("s_waitcnt vmcnt(" #n ")" ::: "memory")
#define PG8_WAIT_L(n) asm volatile("s_waitcnt lgkmcnt(" #n ")" ::: "memory")
#define PG8_BAR __builtin_amdgcn_s_barrier()
#define PG8_SCHED __builtin_amdgcn_sched_barrier(0)
    Unit cur, nxt; int ui = 0;
    if (!S.next(0, cur)) return;
    f32x4 acc[2][2][4][2];
#pragma unroll
    for (int a = 0; a < 2; ++a)
#pragma unroll
        for (int b = 0; b < 2; ++b)
#pragma unroll
            for (int m = 0; m < 4; ++m)
#pragma unroll
                for (int n = 0; n < 2; ++n) acc[a][b][m][n] = (f32x4){0.f, 0.f, 0.f, 0.f};
    bf16x8 At[4][2], B0[2][2], B1[2][2];
    const char* cA = (const char*)g.A + (size_t)cur.pm * tstep; const char* cB = (const char*)g.Bt + (size_t)cur.pn * tstep;
    S.a_ready(cur);
    PG8_STAGE(PG8_SB(0, 0), cB, voffB); PG8_STAGE(PG8_SA(0, 0), cA, voffA); PG8_STAGE(PG8_SB(0, 1), cB + hstep, voffB); PG8_STAGE(PG8_SA(0, 1), cA + hstep, voffA);
    if (wr == 1) PG8_BAR;
    PG8_WAIT_V(4); PG8_BAR;
    PG8_STAGE(PG8_SB(1, 0), cB + kstep, voffB); PG8_STAGE(PG8_SA(1, 0), cA + kstep, voffA); PG8_STAGE(PG8_SB(1, 1), cB + hstep + kstep, voffB);
    PG8_WAIT_V(6); PG8_BAR;
    PG8_STAMP();
    for (;;) {
        const bool has_next = S.next(ui + 1, nxt);
        const char* nA = has_next ? (const char*)g.A + (size_t)nxt.pm * tstep : cA; const char* nB = has_next ? (const char*)g.Bt + (size_t)nxt.pn * tstep : cB;
        for (int t = 0; t < nt; t += 2) {
            const bool last = (t == nt - 2);
            const char* a1 = cA + (size_t)(t + 1) * kstep;
            const char* a2 = last ? nA : cA + (size_t)(t + 2) * kstep; const char* b2 = last ? nB : cB + (size_t)(t + 2) * kstep;
            const char* a3 = a2 + kstep; const char* b3 = b2 + kstep;
            if (last && has_next) S.a_ready(nxt);
            PG8_LDB(B0, 0, 0); PG8_SCHED; PG8_LDA(At, 0, 0); PG8_STAGE(PG8_SA(1, 1), a1 + hstep, voffA);
            PG8_WAIT_L(8); PG8_BAR; PG8_WAIT_L(0); PG8_MMA(0, 0, At, B0); PG8_BAR; PG8_SCHED;
            PG8_LDB(B1, 0, 1); PG8_STAGE(PG8_SB(0, 0), b2, voffB);
            PG8_BAR; PG8_WAIT_L(0); PG8_MMA(0, 1, At, B1); PG8_BAR;
            PG8_LDA(At, 0, 1); PG8_STAGE(PG8_SA(0, 0), a2, voffA);
            PG8_BAR; PG8_WAIT_L(0); PG8_MMA(1, 0, At, B0); PG8_BAR; PG8_SCHED;
            PG8_STAGE(PG8_SB(0, 1), b2 + hstep, voffB);
            PG8_WAIT_V(6); PG8_BAR; PG8_MMA(1, 1, At, B1); PG8_BAR;
            PG8_LDB(B0, 1, 0); PG8_SCHED; PG8_LDA(At, 1, 0); PG8_STAGE(PG8_SA(0, 1), a2 + hstep, voffA);
            PG8_WAIT_L(8); PG8_BAR; PG8_WAIT_L(0); PG8_MMA(0, 0, At, B0); PG8_BAR; PG8_SCHED;
            PG8_LDB(B1, 1, 1); PG8_STAGE(PG8_SB(1, 0), b3, voffB);
            PG8_BAR; PG8_WAIT_L(0); PG8_MMA(0, 1, At, B1); PG8_BAR;
            PG8_LDA(At, 1, 1); PG8_STAGE(PG8_SA(1, 0), a3, voffA);
            PG8_BAR; PG8_WAIT_L(0); PG8_MMA(1, 0, At, B0); PG8_BAR; PG8_SCHED;
            PG8_STAGE(PG8_SB(1, 1), b3 + hstep, voffB);
            PG8_WAIT_V(6); PG8_BAR; PG8_MMA(1, 1, At, B1); PG8_BAR;
        }
        PG8_STAMP();
        if constexpr (!Epi::AFTER_DRAIN) { E(acc, cur, wr, wc, fr, fq); S.done(cur); }
        PG8_STAMP();
        if (!has_next) break;
#pragma unroll
        for (int a = 0; a < 2; ++a)
#pragma unroll
            for (int b = 0; b < 2; ++b)
#pragma unroll
                for (int m = 0; m < 4; ++m)
#pragma unroll
                    for (int n = 0; n < 2; ++n) acc[a][b][m][n] = (f32x4){0.f, 0.f, 0.f, 0.f};
        cur = nxt; cA = nA; cB = nB; ++ui;
    }
    PG8_WAIT_V(0);
    if (wr == 0) PG8_BAR;
    PG8_BAR;
    if constexpr (Epi::AFTER_DRAIN) { E.fused(acc, cur, wr, wc, fr, fq, lds, wid, lane); S.done(cur); }
    PG8_STAMP();
    if (STAMP && wid == 0) { stamps[lane] = lane < nts ? (((unsigned long long)(unsigned)ts_hi << 32) | (unsigned)ts_lo) : 0ull;
        if (lane == 62) stamps[62] = rt_entry; if (lane == 63) stamps[63] = (unsigned long long)wall_clock64(); }
#undef PG8_STAMP
#undef PG8_SA
#undef PG8_SB
#undef PG8_STAGE
#undef PG8_LDA
#undef PG8_LDB
#undef PG8_MMA
#undef PG8_WAIT_V
#undef PG8_WAIT_L
#undef PG8_BAR
#undef PG8_SCHED
}
}

using pg8::bf16_t; using pg8::bf16x8; using pg8::f32x4; using pg8::u32x4;
#define LAS __attribute__((address_space(3)))
typedef LAS unsigned char* lds_t;
typedef LAS bf16_t* lbf_t;
typedef LAS float* lf_t;
typedef unsigned u32x2 __attribute__((ext_vector_type(2)));

constexpr int MP = 16384, MSM = 512, MT = MP + MSM, MODN = 14336;
constexpr float EPS = 1e-6f;
constexpr size_t WS_WT_RET_IN = 0;
constexpr size_t WS_WT_RET_OUT = WS_WT_RET_IN + (size_t)6144 * 1024 * 2;
constexpr size_t WS_WT_GDN_IN = WS_WT_RET_OUT + (size_t)1024 * 2048 * 2;
constexpr size_t WS_WT_GDN_OUT = WS_WT_GDN_IN + (size_t)6400 * 1024 * 2;
constexpr size_t WS_WT_UP = WS_WT_GDN_OUT + (size_t)1024 * 2048 * 2;
constexpr size_t WS_WT_DOWN = WS_WT_UP + (size_t)2 * 5632 * 1024 * 2;
constexpr size_t WS_WT_ADA = WS_WT_DOWN + (size_t)2 * 1024 * 2816 * 2;
constexpr size_t WS_CS = WS_WT_ADA + (size_t)14336 * 1024 * 2;
constexpr size_t WS_MODB = WS_CS + (size_t)256 * 1024 * 2;
constexpr size_t WS_MOD = WS_MODB + (size_t)14336 * 4;
constexpr size_t WS_ROPE = WS_MOD + (size_t)256 * 14336 * 4;
constexpr size_t WS_XA = WS_ROPE + (size_t)2 * 2052 * 128 * 4;
constexpr size_t WS_XB = WS_XA + (size_t)MT * 1024 * 4;
constexpr size_t WS_H = WS_XB + (size_t)MT * 1024 * 4;
constexpr size_t WS_PROJ = WS_H + (size_t)MT * 1024 * 2;
constexpr size_t WS_BA = WS_PROJ + (size_t)MT * 6144 * 2;
constexpr size_t WS_OG = WS_BA + (size_t)MT * 32 * 4;
constexpr size_t WS_SSQ = WS_OG + (size_t)MT * 2048 * 2;
constexpr size_t WS_R2 = WS_SSQ + (size_t)MT * 64 * 4;
constexpr size_t GREC = 73728 + 256;
constexpr size_t WS_U = WS_R2;
constexpr size_t WS_ACT = WS_R2 + (size_t)MT * 5632 * 2;
constexpr size_t WS_ORAW = WS_R2;
constexpr size_t WS_END = WS_R2 + (size_t)4096 * GREC;
constexpr size_t O_YP = 0, O_YS = O_YP + (size_t)MP * 1024, O_RETP = O_YS + (size_t)MSM * 1024, O_GDNP = O_RETP + (size_t)8 * 4 * 256 * 512,
                 O_GCP = O_GDNP + (size_t)8 * 16 * 128 * 128, O_FCP = O_GCP + (size_t)8 * 3 * 4096, O_RETS = O_FCP + (size_t)2 * 8 * 2 * 2816,
                 O_GDNS = O_RETS + (size_t)128 * 4 * 256 * 512, O_GCS = O_GDNS + (size_t)128 * 16 * 128 * 128, O_FCS = O_GCS + (size_t)128 * 3 * 4096;
constexpr int LDS_BYTES = 160 * 1024;

struct Params { const float* in[27]; float* out; unsigned char* ws; int ph_lo, ph_hi; };

__device__ __forceinline__ float bf2f(bf16_t b) { return __uint_as_float(((unsigned)b) << 16); }
__device__ __forceinline__ float bflo(unsigned u) { return __uint_as_float(u << 16); }
__device__ __forceinline__ float bfhi(unsigned u) { return __uint_as_float(u & 0xffff0000u); }
__device__ __forceinline__ bf16_t f2bf(float f) { unsigned u = __float_as_uint(f); u += 0x7FFFu + ((u >> 16) & 1u); return (bf16_t)(u >> 16); }
__device__ __forceinline__ unsigned pk2(float lo, float hi) { return (unsigned)f2bf(lo) | ((unsigned)f2bf(hi) << 16); }
__device__ __forceinline__ float silu_f(float x) { return x / (1.f + __expf(-x)); }
__device__ __forceinline__ float sigmoid_f(float x) { return 1.f / (1.f + __expf(-x)); }
__device__ __forceinline__ void unpack8(const u32x4 v, float* f) { f[0] = bflo(v.x); f[1] = bfhi(v.x); f[2] = bflo(v.y); f[3] = bfhi(v.y); f[4] = bflo(v.z); f[5] = bfhi(v.z); f[6] = bflo(v.w); f[7] = bfhi(v.w); }
__device__ __forceinline__ u32x4 pack8(const float* f) { u32x4 v; v.x = pk2(f[0], f[1]); v.y = pk2(f[2], f[3]); v.z = pk2(f[4], f[5]); v.w = pk2(f[6], f[7]); return v; }

template <int KS> __device__ __forceinline__ void mma16(f32x4& acc, lbf_t X, int ldx, lbf_t Y, int ldy, int lane) {
    lbf_t xp = X + (lane & 15) * ldx + (lane >> 4) * 8;
    lbf_t yp = Y + (lane & 15) * ldy + (lane >> 4) * 8;
#pragma unroll
    for (int k = 0; k < KS; ++k) {
        const bf16x8 a = *(const LAS bf16x8*)(xp + k * 32);
        const bf16x8 b = *(const LAS bf16x8*)(yp + k * 32);
        acc = __builtin_amdgcn_mfma_f32_16x16x32_bf16(a, b, acc, 0, 0, 0);
    }
}

__device__ void transpose_convert(const float* __restrict__ src, int K, int N, bf16_t* __restrict__ dst, int Npad, lds_t lds, int bid, int nb, int tid) {
    lf_t tl = (lf_t)lds;
    const int nTn = Npad / 64, ntiles = (K / 64) * nTn;
    for (int tile = bid; tile < ntiles; tile += nb) {
        const int k0 = (tile / nTn) * 64, n0 = (tile % nTn) * 64;
#pragma unroll
        for (int e = 0; e < 2; ++e) {
            const int kk = (tid >> 4) + e * 32, nn = (tid & 15) * 4;
            f32x4 v = (f32x4){0.f, 0.f, 0.f, 0.f};
            if (n0 + nn < N) v = *(const f32x4*)(src + (size_t)(k0 + kk) * N + n0 + nn);
            tl[kk * 65 + nn] = v[0]; tl[kk * 65 + nn + 1] = v[1]; tl[kk * 65 + nn + 2] = v[2]; tl[kk * 65 + nn + 3] = v[3];
        }
        __syncthreads();
        { const int n = tid >> 3, kc = (tid & 7) * 8; float f[8];
#pragma unroll
          for (int j = 0; j < 8; ++j) f[j] = tl[(kc + j) * 65 + n];
          *(u32x4*)(dst + (size_t)(n0 + n) * K + k0 + kc) = pack8(f); }
        __syncthreads();
    }
}

__device__ void phase_prep(const Params& P, lds_t lds, int bid, int nb, int tid) {
    unsigned char* ws = P.ws;
    transpose_convert(P.in[15], 1024, 6144, (bf16_t*)(ws + WS_WT_RET_IN), 6144, lds, bid, nb, tid);
    transpose_convert(P.in[8], 1024, 6144, (bf16_t*)(ws + WS_WT_ADA), 6144, lds, bid, nb, tid);
    transpose_convert(P.in[8] + (size_t)1024 * 6144, 1024, 6144, (bf16_t*)(ws + WS_WT_ADA) + (size_t)6144 * 1024, 6144, lds, bid, nb, tid);
    transpose_convert(P.in[10], 1024, 2048, (bf16_t*)(ws + WS_WT_ADA) + (size_t)12288 * 1024, 2048, lds, bid, nb, tid);
    transpose_convert(P.in[16], 2048, 1024, (bf16_t*)(ws + WS_WT_RET_OUT), 1024, lds, bid, nb, tid);
    transpose_convert(P.in[17], 1024, 6176, (bf16_t*)(ws + WS_WT_GDN_IN), 6400, lds, bid, nb, tid);
    transpose_convert(P.in[22], 2048, 1024, (bf16_t*)(ws + WS_WT_GDN_OUT), 1024, lds, bid, nb, tid);
    for (int l = 0; l < 2; ++l) {
        transpose_convert(P.in[23] + (size_t)l * 1024 * 5632, 1024, 5632, (bf16_t*)(ws + WS_WT_UP) + (size_t)l * 5632 * 1024, 5632, lds, bid, nb, tid);
        transpose_convert(P.in[26] + (size_t)l * 2816 * 1024, 2816, 1024, (bf16_t*)(ws + WS_WT_DOWN) + (size_t)l * 1024 * 2816, 1024, lds, bid, nb, tid);
    }
    const int gt = bid * 512 + tid, gs = nb * 512;
    bf16_t* cs = (bf16_t*)(ws + WS_CS);
    for (int i = gt; i < 256 * 1024; i += gs) {
        const int r = i >> 10, c = i & 1023; float v = 0.f;
        if (r < 8) v = silu_f(P.in[6][r * 1024 + c]); else if (r < 136) v = silu_f(P.in[7][(r - 8) * 1024 + c]);
        cs[i] = f2bf(v);
    }
    float* modb = (float*)(ws + WS_MODB);
    for (int i = gt; i < MODN; i += gs) modb[i] = i < 12288 ? P.in[9][i] : P.in[11][i - 12288];
    float* rc = (float*)(ws + WS_ROPE); float* rs = rc + 2052 * 128;
    for (int i = gt; i < 2052 * 128; i += gs) {
        const int p = i >> 7, j = i & 127; const double pos = p < 2048 ? (double)p : (double)(16384 + p - 2048);
        const double inv = exp2(-(double)j * (13.287712379549449 / 128.0));
        double s, c; sincos(pos * inv, &s, &c); rc[i] = (float)c; rs[i] = (float)s;
    }
}

__device__ void phase_adaln(const Params& P, const float* xp, const float* xs, const float* gw, int sh_off, int sc_off, bf16_t* h, float* yp, float* ys, int bid, int nb, int tid) {
    const float* mod = (const float*)(P.ws + WS_MOD);
    const int lane = tid & 63, w = tid >> 6;
    for (int row = bid * 8 + w; row < MT; row += nb * 8) {
        const float* x = row < MP ? xp + (size_t)row * 1024 : xs + (size_t)(row - MP) * 1024;
        const int seq = row < MP ? (row >> 11) : 8 + ((row - MP) >> 2);
        f32x4 v[4]; float ss = 0.f;
#pragma unroll
        for (int i = 0; i < 4; ++i) { v[i] = *(const f32x4*)(x + i * 256 + lane * 4); ss += v[i][0] * v[i][0] + v[i][1] * v[i][1] + v[i][2] * v[i][2] + v[i][3] * v[i][3]; }
#pragma unroll
        for (int o = 32; o >= 1; o >>= 1) ss += __shfl_xor(ss, o);
        const float r = rsqrtf(ss * (1.f / 1024.f) + EPS);
        const float* shp = mod + (size_t)seq * MODN + sh_off; const float* scp = mod + (size_t)seq * MODN + sc_off;
#pragma unroll
        for (int i = 0; i < 4; ++i) {
            const int c = i * 256 + lane * 4;
            const f32x4 g = *(const f32x4*)(gw + c), sh = *(const f32x4*)(shp + c), sc = *(const f32x4*)(scp + c);
            f32x4 o = v[i] * r * g * (sc + 1.f) + sh;
            if (h) { u32x2 pkd; pkd.x = pk2(o[0], o[1]); pkd.y = pk2(o[2], o[3]); *(u32x2*)(h + (size_t)row * 1024 + c) = pkd; }
            else { float* y = row < MP ? yp + (size_t)row * 1024 : ys + (size_t)(row - MP) * 1024; *(f32x4*)(y + c) = o; }
        }
    }
}

struct EpiResid {
    static constexpr bool PERM = false, AFTER_DRAIN = false;
    const float* bp; const float* bs; float* out; const float* gate;
    __device__ __forceinline__ void operator()(const f32x4 (&acc)[2][2][4][2], const pg8::Unit& u, int wr, int wc, int fr, int fq) const {
        const int row0 = u.pm * 256 + wr * 64 + fr, col0 = u.pn * 256 + wc * 32 + 4 * fq;
#pragma unroll
        for (int ai = 0; ai < 2; ++ai)
#pragma unroll
            for (int m = 0; m < 4; ++m) {
                const int row = row0 + ai * 128 + m * 16;
                const int seq = row < MP ? (row >> 11) : 8 + ((row - MP) >> 2);
                const float* base = row < MP ? bp + (size_t)row * 1024 : bs + (size_t)(row - MP) * 1024;
                const float* gp = gate + (size_t)seq * MODN; float* op = out + (size_t)row * 1024;
#pragma unroll
                for (int bj = 0; bj < 2; ++bj)
#pragma unroll
                    for (int n = 0; n < 2; ++n) { const int c = col0 + bj * 128 + n * 16;
                        *(f32x4*)(op + c) = *(const f32x4*)(base + c) + *(const f32x4*)(gp + c) * acc[ai][bj][m][n]; }
            }
    }
};
struct EpiUp {
    static constexpr bool PERM = true, AFTER_DRAIN = false;
    bf16_t* U; float* fcp; float* fcs;
    __device__ __forceinline__ void operator()(const f32x4 (&acc)[2][2][4][2], const pg8::Unit& u, int wr, int wc, int fr, int fq) const {
        const int row0 = u.pm * 256 + wr * 64 + fr, col0 = u.pn * 256 + wc * 32 + 8 * fq;
#pragma unroll
        for (int ai = 0; ai < 2; ++ai)
#pragma unroll
            for (int m = 0; m < 4; ++m) {
                const int row = row0 + ai * 128 + m * 16; float* cp = nullptr;
                if (row < MP) { const int t = row & 2047; if (t >= 2046) cp = fcp + (size_t)((row >> 11) * 2 + (t - 2046)) * 2816; }
                else { const int rs = row - MP, t = rs & 3; if (t >= 2) cp = fcs + (size_t)((rs >> 2) * 2 + (t - 2)) * 2816; }
#pragma unroll
                for (int bj = 0; bj < 2; ++bj) { const int c = col0 + bj * 128; const f32x4 v0 = acc[ai][bj][m][0], v1 = acc[ai][bj][m][1];
                    u32x4 w; w.x = pg8::cvt_pk_bf16(v0[0], v0[1]); w.y = pg8::cvt_pk_bf16(v0[2], v0[3]); w.z = pg8::cvt_pk_bf16(v1[0], v1[1]); w.w = pg8::cvt_pk_bf16(v1[2], v1[3]);
                    *(u32x4*)(U + (size_t)row * 5632 + c) = w;
                    if (cp && c < 2816) { *(f32x4*)(cp + c) = v0; *(f32x4*)(cp + c + 4) = v1; } }
            }
    }
};
struct EpiGdnIn {
    static constexpr bool PERM = true, AFTER_DRAIN = false;
    bf16_t* proj; float* ba; float* gcp; float* gcs;
    __device__ __forceinline__ void operator()(const f32x4 (&acc)[2][2][4][2], const pg8::Unit& u, int wr, int wc, int fr, int fq) const {
        const int row0 = u.pm * 256 + wr * 64 + fr, col0 = u.pn * 256 + wc * 32 + 8 * fq;
#pragma unroll
        for (int ai = 0; ai < 2; ++ai)
#pragma unroll
            for (int m = 0; m < 4; ++m) {
                const int row = row0 + ai * 128 + m * 16; float* cp = nullptr;
                if (row < MP) { const int t = row & 2047; if (t >= 2045) cp = gcp + (size_t)((row >> 11) * 3 + (t - 2045)) * 4096; }
                else { const int rs = row - MP, t = rs & 3; if (t >= 1) cp = gcs + (size_t)((rs >> 2) * 3 + (t - 1)) * 4096; }
#pragma unroll
                for (int bj = 0; bj < 2; ++bj) { const int c = col0 + bj * 128; const f32x4 v0 = acc[ai][bj][m][0], v1 = acc[ai][bj][m][1];
                    if (c < 6144) {
                        u32x4 w; w.x = pg8::cvt_pk_bf16(v0[0], v0[1]); w.y = pg8::cvt_pk_bf16(v0[2], v0[3]); w.z = pg8::cvt_pk_bf16(v1[0], v1[1]); w.w = pg8::cvt_pk_bf16(v1[2], v1[3]);
                        *(u32x4*)(proj + (size_t)row * 6144 + c) = w;
                        if (cp && c < 4096) { *(f32x4*)(cp + c) = v0; *(f32x4*)(cp + c + 4) = v1; }
                    } else if (c < 6176) { float* bp = ba + (size_t)row * 32 + (c - 6144); *(f32x4*)bp = v0; *(f32x4*)(bp + 4) = v1; } }
            }
    }
};

template <class Epi> __device__ __forceinline__ void run_gemm(lds_t lds, const bf16_t* A, const bf16_t* Bt, int M, int N, int K, const Epi& E, int bid, int nb) {
    pg8::Gemm g{A, Bt, M, N, K}; pg8::StaticOrder S; S.init(M, N, nb, bid);
    pg8::gemm_phase<Epi, pg8::StaticOrder, false>(lds, g, S, E, nullptr);
    __syncthreads();
}

__device__ void phase_post_ret(const Params& P, int bid, int nb, int tid) {
    const bf16_t* oraw = (const bf16_t*)(P.ws + WS_ORAW); const bf16_t* proj = (const bf16_t*)(P.ws + WS_PROJ);
    const float* ssq = (const float*)(P.ws + WS_SSQ); bf16_t* og = (bf16_t*)(P.ws + WS_OG);
    for (int u = bid * 512 + tid; u < MT * 256; u += nb * 512) {
        const int row = u >> 8, col = (u & 255) * 8, h = col >> 9;
        const f32x4* sp = (const f32x4*)(ssq + (size_t)row * 64 + h * 16);
        const f32x4 s0 = sp[0], s1 = sp[1], s2 = sp[2], s3 = sp[3];
        const float ss = (s0[0] + s0[1] + s0[2] + s0[3]) + (s1[0] + s1[1] + s1[2] + s1[3]) + (s2[0] + s2[1] + s2[2] + s2[3]) + (s3[0] + s3[1] + s3[2] + s3[3]);
        const float r = rsqrtf(ss * (1.f / 512.f) + EPS);
        float o[8], g[8];
        unpack8(*(const u32x4*)(oraw + (size_t)row * 2048 + col), o); unpack8(*(const u32x4*)(proj + (size_t)row * 6144 + 4096 + col), g);
#pragma unroll
        for (int j = 0; j < 8; ++j) o[j] = o[j] * r * silu_f(g[j]);
        *(u32x4*)(og + (size_t)row * 2048 + col) = pack8(o);
    }
}
__device__ void phase_act(const Params& P, int l, int bid, int nb, int tid) {
    const bf16_t* U = (const bf16_t*)(P.ws + WS_U); bf16_t* act = (bf16_t*)(P.ws + WS_ACT);
    const float* wdw = P.in[24] + (size_t)l * 3 * 2816; const float* bdw = P.in[25] + (size_t)l * 2816;
    for (int u = bid * 512 + tid; u < MT * 352; u += nb * 512) {
        const int row = u / 352, f = (u - row * 352) * 8;
        float g0[8], g1[8], g2[8], vv[8];
        const bf16_t* up = U + (size_t)row * 5632 + f;
        unpack8(*(const u32x4*)up, g0); unpack8(*(const u32x4*)(up + 2816), vv);
        if (row < MP) {
            const int t = row & 2047;
            if (t >= 1) unpack8(*(const u32x4*)(up - 5632), g1); else { for (int j = 0; j < 8; ++j) g1[j] = 0.f; }
            if (t >= 2) unpack8(*(const u32x4*)(up - 2 * 5632), g2); else { for (int j = 0; j < 8; ++j) g2[j] = 0.f; }
        } else {
            const int rs = row - MP, t = rs & 3, b = rs >> 2;
            const float* buf = P.in[5] + (size_t)((l * 128 + b) * 2) * 2816 + f;
            if (t >= 1) unpack8(*(const u32x4*)(up - 5632), g1); else { for (int j = 0; j < 8; ++j) g1[j] = buf[2816 + j]; }
            if (t >= 2) unpack8(*(const u32x4*)(up - 2 * 5632), g2); else { for (int j = 0; j < 8; ++j) g2[j] = buf[t * 2816 + j]; }
        }
        float o[8];
#pragma unroll
        for (int j = 0; j < 8; ++j) { const float cv = wdw[f + j] * g2[j] + wdw[2816 + f + j] * g1[j] + wdw[2 * 2816 + f + j] * g0[j] + bdw[f + j]; o[j] = silu_f(cv) * vv[j]; }
        *(u32x4*)(act + (size_t)row * 2816 + f) = pack8(o);
    }
}

__device__ void ret_prompt_task(const Params& P, int task, lds_t lds, int tid) {
    asm volatile("" : "+v"(tid));
    const int b = task >> 5, h = (task >> 3) & 3, sl = task & 7;
    const int lane = tid & 63, w = tid >> 6, q4 = lane >> 4, l16 = lane & 15;
    const bf16_t* proj = (const bf16_t*)(P.ws + WS_PROJ);
    const float* ropec = (const float*)(P.ws + WS_ROPE); const float* ropes = ropec + 2052 * 128;
    bf16_t* oraw = (bf16_t*)(P.ws + WS_ORAW); float* ssq = (float*)(P.ws + WS_SSQ);
    lbf_t Qs = (lbf_t)lds, Ks = Qs + 64 * 264, KdT = Ks + 64 * 264, VT = KdT + 256 * 72, Ps = VT + 64 * 72, ST = Ps + 64 * 72;
    const float lg2 = log2f(1.0f - exp2f(-5.0f - (float)h));
    const float cd = exp2f(64.f * lg2);
    f32x4 Sacc[8];
#pragma unroll
    for (int i = 0; i < 8; ++i) Sacc[i] = (f32x4){0.f, 0.f, 0.f, 0.f};
    for (int i = tid; i < 64 * 264 / 2; i += 512) ((LAS unsigned*)ST)[i] = 0u;
    u32x4 rq1[2], rq2[2], rk1[2], rk2[2], rv; f32x4 rc[2][2], rs[2][2];
    const int vt = tid >> 3, vc8 = tid & 7;
#define RET_LOAD(n) do { _Pragma("unroll") for (int e = 0; e < 2; ++e) { const int u = tid + e * 512, t = u >> 4, c8 = u & 15; \
        const bf16_t* bp = proj + (size_t)(b * 2048 + (n) * 64 + t) * 6144 + h * 256 + c8 * 8; \
        rq1[e] = *(const u32x4*)bp; rq2[e] = *(const u32x4*)(bp + 128); rk1[e] = *(const u32x4*)(bp + 1024); rk2[e] = *(const u32x4*)(bp + 1024 + 128); \
        const float* cp = ropec + (size_t)((n) * 64 + t) * 128 + c8 * 8; const float* sp = ropes + (size_t)((n) * 64 + t) * 128 + c8 * 8; \
        rc[e][0] = *(const f32x4*)cp; rc[e][1] = *(const f32x4*)(cp + 4); rs[e][0] = *(const f32x4*)sp; rs[e][1] = *(const f32x4*)(sp + 4); } \
        rv = *(const u32x4*)(proj + (size_t)(b * 2048 + (n) * 64 + vt) * 6144 + 2048 + h * 512 + sl * 64 + vc8 * 8); } while (0)
    RET_LOAD(0);
    for (int n_ = 0; n_ < 32; ++n_) {
        int n = n_; asm volatile("" : "+s"(n));
#pragma unroll
        for (int e = 0; e < 2; ++e) {
            const int u = tid + e * 512, t = u >> 4, c8 = u & 15;
            float q1[8], q2[8], k1[8], k2[8], a[8], c[8];
            unpack8(rq1[e], q1); unpack8(rq2[e], q2); unpack8(rk1[e], k1); unpack8(rk2[e], k2);
            const float kd = exp2f((float)(63 - t) * lg2);
#pragma unroll
            for (int j = 0; j < 8; ++j) { const float co = rc[e][j >> 2][j & 3], si = rs[e][j >> 2][j & 3]; a[j] = q1[j] * co - q2[j] * si; c[j] = q1[j] * si + q2[j] * co; }
            *(LAS u32x4*)(Qs + t * 264 + c8 * 8) = pack8(a); *(LAS u32x4*)(Qs + t * 264 + 128 + c8 * 8) = pack8(c);
#pragma unroll
            for (int j = 0; j < 8; ++j) { const float co = rc[e][j >> 2][j & 3], si = rs[e][j >> 2][j & 3]; a[j] = (k1[j] * co - k2[j] * si) * 0.0625f; c[j] = (k1[j] * si + k2[j] * co) * 0.0625f; }
            *(LAS u32x4*)(Ks + t * 264 + c8 * 8) = pack8(a); *(LAS u32x4*)(Ks + t * 264 + 128 + c8 * 8) = pack8(c);
#pragma unroll
            for (int j = 0; j < 8; ++j) { KdT[(c8 * 8 + j) * 72 + t] = f2bf(a[j] * kd); KdT[(128 + c8 * 8 + j) * 72 + t] = f2bf(c[j] * kd); }
        }
        { const unsigned vw[4] = {rv.x, rv.y, rv.z, rv.w};
#pragma unroll
          for (int j = 0; j < 4; ++j) { VT[(vc8 * 8 + 2 * j) * 72 + vt] = (bf16_t)(vw[j] & 0xffffu); VT[(vc8 * 8 + 2 * j + 1) * 72 + vt] = (bf16_t)(vw[j] >> 16); } }
        __syncthreads();
        if (n + 1 < 32) RET_LOAD(n + 1);
        { const int ib = w & 3, i = ib * 16 + l16;
#pragma unroll
          for (int jj = 0; jj < 2; ++jj) { const int jb = (w >> 2) * 2 + jj; f32x4 acc = (f32x4){0.f, 0.f, 0.f, 0.f};
              if (jb <= ib) mma16<8>(acc, Ks + jb * 16 * 264, 264, Qs + ib * 16 * 264, 264, lane);
              const int j0 = jb * 16 + 4 * q4; float pv[4];
#pragma unroll
              for (int r = 0; r < 4; ++r) { const int j = j0 + r; pv[r] = (i >= j) ? acc[r] * exp2f((float)(i - j) * lg2) : 0.f; }
              u32x2 pkd; pkd.x = pk2(pv[0], pv[1]); pkd.y = pk2(pv[2], pv[3]); *(LAS u32x2*)(Ps + i * 72 + j0) = pkd; } }
        __syncthreads();
        { const int ib = w & 3, i = ib * 16 + l16; const float qd = exp2f((float)(i + 1) * lg2); float ss = 0.f;
          const size_t row = (size_t)b * 2048 + n * 64 + i;
#pragma unroll
          for (int dd = 0; dd < 2; ++dd) { const int dvb = (w >> 2) * 2 + dd; f32x4 acc = (f32x4){0.f, 0.f, 0.f, 0.f};
              mma16<8>(acc, ST + dvb * 16 * 264, 264, Qs + ib * 16 * 264, 264, lane);
              acc = acc * qd;
              mma16<2>(acc, VT + dvb * 16 * 72, 72, Ps + ib * 16 * 72, 72, lane);
              ss += acc[0] * acc[0] + acc[1] * acc[1] + acc[2] * acc[2] + acc[3] * acc[3];
              u32x2 pkd; pkd.x = pk2(acc[0], acc[1]); pkd.y = pk2(acc[2], acc[3]);
              *(u32x2*)(oraw + row * 2048 + h * 512 + sl * 64 + dvb * 16 + 4 * q4) = pkd; }
          ss += __shfl_xor(ss, 16); ss += __shfl_xor(ss, 32);
          if (q4 == 0) ssq[row * 64 + h * 16 + sl * 2 + (w >> 2)] = ss; }
#pragma unroll
        for (int a = 0; a < 2; ++a)
#pragma unroll
            for (int d = 0; d < 4; ++d) { Sacc[a * 4 + d] = Sacc[a * 4 + d] * cd; mma16<2>(Sacc[a * 4 + d], KdT + (w * 32 + a * 16) * 72, 72, VT + d * 16 * 72, 72, lane); }
        __syncthreads();
#pragma unroll
        for (int a = 0; a < 2; ++a)
#pragma unroll
            for (int d = 0; d < 4; ++d) { const f32x4 s = Sacc[a * 4 + d]; u32x2 pkd; pkd.x = pk2(s[0], s[1]); pkd.y = pk2(s[2], s[3]);
                *(LAS u32x2*)(ST + (d * 16 + l16) * 264 + w * 32 + a * 16 + 4 * q4) = pkd; }
    }
#undef RET_LOAD
    float* so = P.out + O_RETP + (size_t)(b * 4 + h) * 256 * 512 + sl * 64 + (size_t)(w * 32 + 4 * q4) * 512 + l16;
    asm volatile("" : "+v"(so));
#pragma unroll
    for (int a = 0; a < 2; ++a)
#pragma unroll
        for (int d = 0; d < 4; ++d)
#pragma unroll
            for (int r = 0; r < 4; ++r) so[(size_t)(a * 16 + r) * 512 + d * 16] = Sacc[a * 4 + d][r];
    __syncthreads();
}

__device__ void ret_sample_task(const Params& P, int task, lds_t lds, int tid) {
    asm volatile("" : "+v"(tid));
    const int b = task >> 4, h = (task >> 2) & 3, sl = task & 3;
    const bf16_t* proj = (const bf16_t*)(P.ws + WS_PROJ);
    const float* ropec = (const float*)(P.ws + WS_ROPE); const float* ropes = ropec + 2052 * 128;
    bf16_t* oraw = (bf16_t*)(P.ws + WS_ORAW); float* ssq = (float*)(P.ws + WS_SSQ);
    lf_t qs = (lf_t)lds, ks = qs + 1024, vs = ks + 1024, red = vs + 512, Am = red + 512, ssr = Am + 16, redp = ssr + 16;
    const float lg2 = log2f(1.0f - exp2f(-5.0f - (float)h));
    const size_t row0 = (size_t)MP + b * 4;
#pragma unroll
    for (int e = 0; e < 2; ++e) {
        const int u = tid + e * 512, mat = u >> 9, t = (u >> 7) & 3, j = u & 127;
        const bf16_t* bp = proj + (row0 + t) * 6144 + mat * 1024 + h * 256 + j;
        const float x1 = bf2f(bp[0]), x2 = bf2f(bp[128]);
        const float co = ropec[(2048 + t) * 128 + j], si = ropes[(2048 + t) * 128 + j];
        const float sc = mat ? 0.0625f : 1.f; lf_t dst = mat ? ks : qs;
        dst[t * 256 + j] = (x1 * co - x2 * si) * sc; dst[t * 256 + 128 + j] = (x1 * si + x2 * co) * sc;
    }
    { const int t = tid >> 7, c = tid & 127; vs[t * 128 + c] = bf2f(proj[(row0 + t) * 6144 + 2048 + h * 512 + sl * 128 + c]); }
    __syncthreads();
    { const int p = tid >> 5, l32 = tid & 31, i = p >> 2, j = p & 3; float s = 0.f;
      for (int d = l32; d < 256; d += 32) s += qs[i * 256 + d] * ks[j * 256 + d];
#pragma unroll
      for (int o = 16; o >= 1; o >>= 1) s += __shfl_xor(s, o);
      if (l32 == 0) Am[p] = (i >= j) ? s * exp2f((float)(i - j) * lg2) : 0.f; }
    __syncthreads();
    { const int c4 = tid & 31, dg = tid >> 5;
      const size_t sbase = ((size_t)(b * 4 + h) * 256) * 512 + sl * 128 + c4 * 4;
      const float* Sin = P.in[2] + sbase; float* Sout = P.out + O_RETS + sbase;
      f32x4 vp[4], pq[4];
#pragma unroll
      for (int j = 0; j < 4; ++j) { vp[j] = *(LAS f32x4*)(vs + j * 128 + c4 * 4) * exp2f((float)(3 - j) * lg2); pq[j] = (f32x4){0.f, 0.f, 0.f, 0.f}; }
      const float g4 = exp2f(4.f * lg2);
#pragma unroll 4
      for (int dd = 0; dd < 16; ++dd) { const int dk = dg * 16 + dd; const f32x4 s = *(const f32x4*)(Sin + (size_t)dk * 512);
          f32x4 sn = s * g4;
#pragma unroll
          for (int i = 0; i < 4; ++i) { pq[i] += s * qs[i * 256 + dk]; sn += vp[i] * ks[i * 256 + dk]; }
          *(f32x4*)(Sout + (size_t)dk * 512) = sn; }
#pragma unroll
      for (int i = 0; i < 4; ++i) *(LAS f32x4*)(redp + (dg * 4 + i) * 128 + c4 * 4) = pq[i]; }
    __syncthreads();
    { float s = 0.f;
#pragma unroll
      for (int g = 0; g < 16; ++g) s += redp[g * 512 + tid];
      red[tid] = s; }
    __syncthreads();
    if (tid < 128) {
        const int dv = tid; float v[4];
#pragma unroll
        for (int j = 0; j < 4; ++j) v[j] = vs[j * 128 + dv];
#pragma unroll
        for (int i = 0; i < 4; ++i) { float o = exp2f((float)(i + 1) * lg2) * red[i * 128 + dv];
#pragma unroll
            for (int j = 0; j < 4; ++j) o += Am[i * 4 + j] * v[j];
            oraw[(row0 + i) * 2048 + h * 512 + sl * 128 + dv] = f2bf(o);
            float s2 = o * o;
#pragma unroll
            for (int of = 32; of >= 1; of >>= 1) s2 += __shfl_xor(s2, of);
            if ((tid & 63) == 0) ssr[(tid >> 6) * 4 + i] = s2; }
    }
    __syncthreads();
    if (tid < 16) { const int i = tid >> 2, k = tid & 3; const int slot = (k == 0) ? sl : 4 + 3 * sl + (k - 1); ssq[(row0 + i) * 64 + h * 16 + slot] = (k == 0) ? ssr[i] + ssr[4 + i] : 0.f; }
    __syncthreads();
}

__device__ void phase_retention(const Params& P, lds_t lds, int bid, int nb, int tid) {
    for (int t = bid; t < 256; t += nb) ret_prompt_task(P, t, lds, tid);
    for (int t = bid; t < 2048; t += nb) ret_sample_task(P, t, lds, tid);
}

__device__ __forceinline__ float softplus_f(float x) { return x > 20.f ? x : log1pf(__expf(x)); }
__device__ __forceinline__ unsigned char* grec(const Params& P, int b, int hv, int n) { return P.ws + WS_R2 + (size_t)((b * 16 + hv) * 32 + n) * GREC; }
constexpr int R_W = 0, R_U = 16384, R_ATT = 32768, R_QG = 40960, R_KG = 57344, R_EGL = 73728;

__device__ void gdn_prep_task(const Params& P, int task, lds_t lds, int tid) {
    asm volatile("" : "+v"(tid));
    const int b_ = task >> 8, hk = (task >> 5) & 7, n = task & 31;
    const int lane = tid & 63, w = tid >> 6, q4 = lane >> 4, l16 = lane & 15;
    const bf16_t* proj = (const bf16_t*)(P.ws + WS_PROJ); const float* ba = (const float*)(P.ws + WS_BA);
    const float* wconv = P.in[18];
    lbf_t Qn = (lbf_t)lds, Kn = Qn + 64 * 136, KbgT = Kn + 64 * 136  , VbT = KbgT + 2 * 128 * 72  ;
    lf_t Lm = (lf_t)(lds + 108544)  , Gs = (lf_t)(lds + 108544 + 2 * 16384)  , Bs = Gs + 128;
    const size_t r0 = (size_t)b_ * 2048 + n * 64;
    if (w < 2) {
        const int hvg = hk * 2 + w; const size_t row = r0 + lane;
        const float a = ba[row * 32 + 16 + hvg], bb = ba[row * 32 + hvg];
        float g = -__expf(P.in[19][hvg]) * softplus_f(a + P.in[20][hvg]);
#pragma unroll
        for (int o = 1; o < 64; o <<= 1) { const float t = __shfl_up(g, o); if (lane >= o) g += t; }
        Gs[w * 64 + lane] = g; Bs[w * 64 + lane] = sigmoid_f(bb);
    }
    __syncthreads();
    { int b = b_; asm volatile("" : "+s"(b)); const int mat = tid >> 8, rsg = (tid >> 4) & 15, cgp = tid & 15;
      {
        const int col = mat * 1024 + hk * 128 + cgp * 8; float x[7][8], wv[4][8];
#pragma unroll
        for (int i = 0; i < 4; ++i) { const f32x4 a0 = *(const f32x4*)(wconv + i * 4096 + col), a1 = *(const f32x4*)(wconv + i * 4096 + col + 4);
            wv[i][0] = a0[0]; wv[i][1] = a0[1]; wv[i][2] = a0[2]; wv[i][3] = a0[3]; wv[i][4] = a1[0]; wv[i][5] = a1[1]; wv[i][6] = a1[2]; wv[i][7] = a1[3]; }
#pragma unroll
        for (int rr = 0; rr < 7; ++rr) { const int t = n * 64 + rsg * 4 - 3 + rr;
            if (t >= 0) unpack8(*(const u32x4*)(proj + ((size_t)b * 2048 + t) * 6144 + col), x[rr]); else { for (int j = 0; j < 8; ++j) x[rr][j] = 0.f; } }
#pragma unroll
        for (int rr = 0; rr < 4; ++rr) {
            float o[8], ss = 0.f;
#pragma unroll
            for (int j = 0; j < 8; ++j) { const float cv = wv[0][j] * x[rr][j] + wv[1][j] * x[rr + 1][j] + wv[2][j] * x[rr + 2][j] + wv[3][j] * x[rr + 3][j]; o[j] = silu_f(cv); ss += o[j] * o[j]; }
            ss += __shfl_xor(ss, 1); ss += __shfl_xor(ss, 2); ss += __shfl_xor(ss, 4); ss += __shfl_xor(ss, 8);
            const float rn = rsqrtf(ss + EPS) * (mat == 0 ? 0.08838834764831845f : 1.f);
#pragma unroll
            for (int j = 0; j < 8; ++j) o[j] *= rn;
            const int r = rsg * 4 + rr;
            *(LAS u32x4*)((mat == 0 ? Qn : Kn) + r * 136 + cgp * 8) = pack8(o);
#pragma unroll
            for (int hv = 0; hv < 2; ++hv) {
                const float G = Gs[hv * 64 + r], Gl = Gs[hv * 64 + 63], be = Bs[hv * 64 + r];
                unsigned char* rec = grec(P, b, hk * 2 + hv, n); float y[8];
                if (mat == 0) { const float e = __expf(G);
#pragma unroll
                    for (int j = 0; j < 8; ++j) y[j] = o[j] * e;
                    *(u32x4*)(rec + R_QG + (r * 128 + cgp * 8) * 2) = pack8(y);
                } else { const float e = __expf(Gl - G), e2 = be * __expf(G);
#pragma unroll
                    for (int j = 0; j < 8; ++j) y[j] = o[j] * e;
                    *(u32x4*)(rec + R_KG + (r * 128 + cgp * 8) * 2) = pack8(y);
#pragma unroll
                    for (int j = 0; j < 8; ++j) KbgT[(hv * 128 + cgp * 8 + j) * 72 + r] = f2bf(o[j] * e2);
                }
            }
        }
      }
      asm volatile("" ::: "memory"); __builtin_amdgcn_sched_barrier(0);
      {
        const int hv = mat, col = 2048 + (hk * 2 + hv) * 128 + cgp * 8; float x[7][8], wv[4][8];
#pragma unroll
        for (int i = 0; i < 4; ++i) { const f32x4 a0 = *(const f32x4*)(wconv + i * 4096 + col), a1 = *(const f32x4*)(wconv + i * 4096 + col + 4);
            wv[i][0] = a0[0]; wv[i][1] = a0[1]; wv[i][2] = a0[2]; wv[i][3] = a0[3]; wv[i][4] = a1[0]; wv[i][5] = a1[1]; wv[i][6] = a1[2]; wv[i][7] = a1[3]; }
#pragma unroll
        for (int rr = 0; rr < 7; ++rr) { const int t = n * 64 + rsg * 4 - 3 + rr;
            if (t >= 0) unpack8(*(const u32x4*)(proj + ((size_t)b * 2048 + t) * 6144 + col), x[rr]); else { for (int j = 0; j < 8; ++j) x[rr][j] = 0.f; } }
#pragma unroll
        for (int rr = 0; rr < 4; ++rr) { const int r = rsg * 4 + rr; const float be = Bs[hv * 64 + r];
#pragma unroll
            for (int j = 0; j < 8; ++j) { const float cv = wv[0][j] * x[rr][j] + wv[1][j] * x[rr + 1][j] + wv[2][j] * x[rr + 2][j] + wv[3][j] * x[rr + 3][j];
                VbT[(hv * 128 + cgp * 8 + j) * 72 + r] = f2bf(silu_f(cv) * be); } }
      }
      if (tid < 2) *(float*)(grec(P, b, hk * 2 + tid, n) + R_EGL) = __expf(Gs[tid * 64 + 63]);
    }
    __syncthreads();
    int b = b_; asm volatile("" : "+s"(b));
    if (w < 4) {
        const int ib = w;
        for (int jb = 0; jb <= ib; ++jb) { f32x4 acc = (f32x4){0.f, 0.f, 0.f, 0.f};
            mma16<4>(acc, Kn + ib * 16 * 136, 136, Kn + jb * 16 * 136, 136, lane);
#pragma unroll
            for (int hv = 0; hv < 2; ++hv) { const int j = jb * 16 + l16; const float Gj = Gs[hv * 64 + j];
#pragma unroll
                for (int r = 0; r < 4; ++r) { const int i = ib * 16 + 4 * q4 + r; Lm[hv * 4096 + i * 64 + j] = (i > j) ? acc[r] * Bs[hv * 64 + i] * __expf(Gs[hv * 64 + i] - Gj) : 0.f; } } }
    } else {
        const int ib = w - 4, i = ib * 16 + l16;
        for (int jb = 0; jb < 4; ++jb) { f32x4 acc = (f32x4){0.f, 0.f, 0.f, 0.f};
            if (jb <= ib) mma16<4>(acc, Kn + jb * 16 * 136, 136, Qn + ib * 16 * 136, 136, lane);
#pragma unroll
            for (int hv = 0; hv < 2; ++hv) { const float Gi = Gs[hv * 64 + i]; float y[4];
#pragma unroll
                for (int r = 0; r < 4; ++r) { const int j = jb * 16 + 4 * q4 + r; y[r] = (i >= j) ? acc[r] * __expf(Gi - Gs[hv * 64 + j]) : 0.f; }
                u32x2 pkd; pkd.x = pk2(y[0], y[1]); pkd.y = pk2(y[2], y[3]);
                *(u32x2*)(grec(P, b, hk * 2 + hv, n) + R_ATT + (i * 64 + jb * 16 + 4 * q4) * 2) = pkd; } }
    }
    __syncthreads();
    if (w < 2) {
        lf_t L = Lm + w * 4096; float t[64];
#pragma unroll
        for (int i = 0; i < 64; ++i) {
            float s0 = (i == lane) ? 1.f : 0.f, s1 = 0.f;
#pragma unroll
            for (int j4 = 0; j4 < (i + 3) / 4; ++j4) { const f32x4 l = *(LAS f32x4*)(L + i * 64 + j4 * 4);
#pragma unroll
                for (int e = 0; e < 4; ++e) { const int j = j4 * 4 + e; if (j < i) { if (e & 1) s1 -= l[e] * t[j]; else s0 -= l[e] * t[j]; } } }
            t[i] = s0 + s1;
        }
        lbf_t T = (lbf_t)L;
#pragma unroll
        for (int i = 0; i < 64; ++i) T[i * 72 + lane] = f2bf(t[i]);
    }
    __syncthreads();
    { int b = b_; asm volatile("" : "+s"(b)); const int hv = w >> 2, kind = (w >> 1) & 1, half = w & 1;
      lbf_t X = (kind ? VbT : KbgT) + hv * 128 * 72; lbf_t T = (lbf_t)(Lm + hv * 4096);
      unsigned char* rec = grec(P, b, hk * 2 + hv, n) + (kind ? R_U : R_W);
#pragma unroll
      for (int db = 0; db < 4; ++db)
#pragma unroll
          for (int ib = 0; ib < 4; ++ib) { const int dkb = half * 4 + db; f32x4 acc = (f32x4){0.f, 0.f, 0.f, 0.f};
              mma16<2>(acc, X + dkb * 16 * 72, 72, T + ib * 16 * 72, 72, lane);
              u32x2 pkd; pkd.x = pk2(acc[0], acc[1]); pkd.y = pk2(acc[2], acc[3]);
              *(u32x2*)(rec + ((ib * 16 + l16) * 128 + dkb * 16 + 4 * q4) * 2) = pkd; } }
    __syncthreads();
}

__device__ void gdn_scan_task(const Params& P, int task, lds_t lds, int tid) {
    asm volatile("" : "+v"(tid));
    const int b = task >> 4, hvg = task & 15;
    const int lane = tid & 63, w = tid >> 6, q4 = lane >> 4, l16 = lane & 15;
    const bf16_t* proj = (const bf16_t*)(P.ws + WS_PROJ); bf16_t* og = (bf16_t*)(P.ws + WS_OG);
    lbf_t Wl = (lbf_t)lds, Ul = Wl + 64 * 136, QGl = Ul + 64 * 136, ATl = QGl + 64 * 136, KgT = ATl + 64 * 72, ST = KgT + 128 * 72, VnT = ST + 128 * 136;
    lf_t Os = (lf_t)lds;
    f32x4 Sacc[8];
#pragma unroll
    for (int i = 0; i < 8; ++i) Sacc[i] = (f32x4){0.f, 0.f, 0.f, 0.f};
    for (int i = tid; i < 128 * 136 / 2; i += 512) ((LAS unsigned*)ST)[i] = 0u;
    u32x4 rw[2], ru[2], rq[2], rk[2], ra, rz[2]; float regl;
    const int nrow = tid >> 3, ncs = (tid & 7) * 16;
    const float* normw = P.in[21];
#define GB_LOAD(n) do { const unsigned char* rec = grec(P, b, hvg, (n)); \
        _Pragma("unroll") for (int e = 0; e < 2; ++e) { const int off = (tid + e * 512) * 16; rw[e] = *(const u32x4*)(rec + R_W + off); ru[e] = *(const u32x4*)(rec + R_U + off); \
            rq[e] = *(const u32x4*)(rec + R_QG + off); rk[e] = *(const u32x4*)(rec + R_KG + off); } \
        ra = *(const u32x4*)(rec + R_ATT + tid * 16); regl = *(const float*)(rec + R_EGL); \
        const bf16_t* zp = proj + ((size_t)b * 2048 + (n) * 64 + nrow) * 6144 + 4096 + hvg * 128 + ncs; rz[0] = *(const u32x4*)zp; rz[1] = *(const u32x4*)(zp + 8); } while (0)
    GB_LOAD(0);
    for (int n_ = 0; n_ < 32; ++n_) {
        int n = n_; asm volatile("" : "+s"(n));
        const float egl = regl; const u32x4 z0 = rz[0], z1 = rz[1];
#pragma unroll
        for (int e = 0; e < 2; ++e) { const int cidx = tid + e * 512, r = cidx >> 4, c8 = cidx & 15;
            *(LAS u32x4*)(Wl + r * 136 + c8 * 8) = rw[e]; *(LAS u32x4*)(Ul + r * 136 + c8 * 8) = ru[e]; *(LAS u32x4*)(QGl + r * 136 + c8 * 8) = rq[e];
            const unsigned kw[4] = {rk[e].x, rk[e].y, rk[e].z, rk[e].w};
#pragma unroll
            for (int j = 0; j < 4; ++j) { KgT[(c8 * 8 + 2 * j) * 72 + r] = (bf16_t)(kw[j] & 0xffffu); KgT[(c8 * 8 + 2 * j + 1) * 72 + r] = (bf16_t)(kw[j] >> 16); } }
        *(LAS u32x4*)(ATl + (tid >> 3) * 72 + (tid & 7) * 8) = ra;
        __syncthreads();
        if (n + 1 < 32) GB_LOAD(n + 1);
        const int ib = w & 3;
#pragma unroll
        for (int dd = 0; dd < 4; ++dd) { const int dvb = (w >> 2) * 4 + dd; f32x4 acc = (f32x4){0.f, 0.f, 0.f, 0.f};
            mma16<4>(acc, Wl + ib * 16 * 136, 136, ST + dvb * 16 * 136, 136, lane);
            float vn[4];
#pragma unroll
            for (int r = 0; r < 4; ++r) vn[r] = bf2f(Ul[(ib * 16 + 4 * q4 + r) * 136 + dvb * 16 + l16]) - acc[r];
            u32x2 pkd; pkd.x = pk2(vn[0], vn[1]); pkd.y = pk2(vn[2], vn[3]);
            *(LAS u32x2*)(VnT + (dvb * 16 + l16) * 72 + ib * 16 + 4 * q4) = pkd; }
        __syncthreads();
        f32x4 oacc[4];
#pragma unroll
        for (int dd = 0; dd < 4; ++dd) { const int dvb = (w >> 2) * 4 + dd; oacc[dd] = (f32x4){0.f, 0.f, 0.f, 0.f};
            mma16<4>(oacc[dd], QGl + ib * 16 * 136, 136, ST + dvb * 16 * 136, 136, lane);
            mma16<2>(oacc[dd], ATl + ib * 16 * 72, 72, VnT + dvb * 16 * 72, 72, lane); }
#pragma unroll
        for (int d = 0; d < 8; ++d) { Sacc[d] = Sacc[d] * egl; mma16<2>(Sacc[d], KgT + w * 16 * 72, 72, VnT + d * 16 * 72, 72, lane); }
        __syncthreads();
#pragma unroll
        for (int d = 0; d < 8; ++d) { const f32x4 s = Sacc[d]; u32x2 pkd; pkd.x = pk2(s[0], s[1]); pkd.y = pk2(s[2], s[3]);
            *(LAS u32x2*)(ST + (d * 16 + l16) * 136 + w * 16 + 4 * q4) = pkd; }
#pragma unroll
        for (int dd = 0; dd < 4; ++dd) { const int dvb = (w >> 2) * 4 + dd;
#pragma unroll
            for (int r = 0; r < 4; ++r) Os[(ib * 16 + 4 * q4 + r) * 132 + dvb * 16 + l16] = oacc[dd][r]; }
        __syncthreads();
        { float o[16], zf[16], ss = 0.f;
#pragma unroll
          for (int j4 = 0; j4 < 4; ++j4) { const f32x4 v = *(LAS f32x4*)(Os + nrow * 132 + ncs + j4 * 4); o[j4 * 4] = v[0]; o[j4 * 4 + 1] = v[1]; o[j4 * 4 + 2] = v[2]; o[j4 * 4 + 3] = v[3]; }
#pragma unroll
          for (int j = 0; j < 16; ++j) ss += o[j] * o[j];
          ss += __shfl_xor(ss, 1); ss += __shfl_xor(ss, 2); ss += __shfl_xor(ss, 4);
          const float rn = rsqrtf(ss * (1.f / 128.f) + EPS);
          unpack8(z0, zf); unpack8(z1, zf + 8);
#pragma unroll
          for (int j = 0; j < 16; ++j) o[j] = o[j] * rn * normw[ncs + j] * silu_f(zf[j]);
          bf16_t* op = og + ((size_t)b * 2048 + n * 64 + nrow) * 2048 + hvg * 128 + ncs;
          *(u32x4*)op = pack8(o); *(u32x4*)(op + 8) = pack8(o + 8); }
        __syncthreads();
    }
#undef GB_LOAD
    float* so = P.out + O_GDNP + (size_t)(b * 16 + hvg) * 128 * 128 + (size_t)(w * 16 + 4 * q4) * 128 + l16;
    asm volatile("" : "+v"(so));
#pragma unroll
    for (int d = 0; d < 8; ++d)
#pragma unroll
        for (int r = 0; r < 4; ++r) so[r * 128 + d * 16] = Sacc[d][r];
    __syncthreads();
}

__device__ void gdn_sample_task(const Params& P, int task, lds_t lds, int tid) {
    asm volatile("" : "+v"(tid));
    const int b = task >> 4, hvg = task & 15, hk = hvg >> 1;
    const int lane = tid & 63, w = tid >> 6;
    const bf16_t* proj = (const bf16_t*)(P.ws + WS_PROJ); const float* ba = (const float*)(P.ws + WS_BA); bf16_t* og = (bf16_t*)(P.ws + WS_OG);
    const float* wconv = P.in[18];
    lf_t qs = (lf_t)lds, ks = qs + 512, vs = ks + 512, us = vs + 512, wsm = us + 512, red = wsm + 512  , vn = red + 1024, on = vn + 512,
         kkd = on + 512, qkd = kkd + 16, Gs = qkd + 16, Bs = Gs + 4, redp = Bs + 4  ;
    const size_t row0 = (size_t)MP + b * 4;
#pragma unroll
    for (int mat = 0; mat < 3; ++mat) {
        const int t = (tid >> 7) & 3, c = tid & 127;
        const int col = mat == 0 ? hk * 128 + c : (mat == 1 ? 1024 + hk * 128 + c : 2048 + hvg * 128 + c);
        float cv = 0.f;
#pragma unroll
        for (int i = 0; i < 4; ++i) { const int r = t + i;
            const float x = r < 3 ? P.in[4][(size_t)(b * 3 + r) * 4096 + col] : bf2f(proj[(row0 + r - 3) * 6144 + col]);
            cv += wconv[i * 4096 + col] * x; }
        (mat == 0 ? qs : (mat == 1 ? ks : vs))[t * 128 + c] = silu_f(cv);
    }
    if (tid == 0) { float G = 0.f;
        for (int t = 0; t < 4; ++t) { const float a = ba[(row0 + t) * 32 + 16 + hvg], bb = ba[(row0 + t) * 32 + hvg];
            G += -__expf(P.in[19][hvg]) * softplus_f(a + P.in[20][hvg]); Gs[t] = G; Bs[t] = sigmoid_f(bb); } }
    __syncthreads();
    { const int mat = w >> 2, t = w & 3; lf_t p = (mat ? ks : qs) + t * 128;
      const float a = p[lane], c = p[lane + 64]; float ss = a * a + c * c;
#pragma unroll
      for (int o = 32; o >= 1; o >>= 1) ss += __shfl_xor(ss, o);
      const float rn = rsqrtf(ss + EPS) * (mat == 0 ? 0.08838834764831845f : 1.f);
      p[lane] = a * rn; p[lane + 64] = c * rn; }
    __syncthreads();
    { const int p = tid >> 4, l = tid & 15, kind = p >> 4, i = (p >> 2) & 3, j = p & 3; lf_t xa = (kind ? qs : ks) + i * 128; float s = 0.f;
      for (int c = l; c < 128; c += 16) s += xa[c] * ks[j * 128 + c];
      s += __shfl_xor(s, 8); s += __shfl_xor(s, 4); s += __shfl_xor(s, 2); s += __shfl_xor(s, 1);
      if (l == 0) (kind ? qkd : kkd)[i * 4 + j] = s; }
    __syncthreads();
    if (tid < 128) { const int c = tid; float u[4], ww[4];
#pragma unroll
        for (int i = 0; i < 4; ++i) { float ru = vs[i * 128 + c] * Bs[i], rw = ks[i * 128 + c] * Bs[i] * __expf(Gs[i]);
#pragma unroll
            for (int j = 0; j < 4; ++j) if (j < i) { const float l = Bs[i] * kkd[i * 4 + j] * __expf(Gs[i] - Gs[j]); ru -= l * u[j]; rw -= l * ww[j]; }
            u[i] = ru; ww[i] = rw; us[i * 128 + c] = ru; wsm[i * 128 + c] = rw; } }
    __syncthreads();
    const int c4 = tid & 31, dg = tid >> 5;
    const size_t sbase = ((size_t)(b * 16 + hvg) * 128 + dg * 8) * 128 + c4 * 4;
    f32x4 S[8];
    { const float* Sin = P.in[3] + sbase; f32x4 pw[4], pq[4];
#pragma unroll
      for (int i = 0; i < 4; ++i) { pw[i] = (f32x4){0.f, 0.f, 0.f, 0.f}; pq[i] = (f32x4){0.f, 0.f, 0.f, 0.f}; }
#pragma unroll
      for (int dd = 0; dd < 8; ++dd) S[dd] = *(const f32x4*)(Sin + dd * 128);
#pragma unroll
      for (int dd = 0; dd < 8; ++dd) { const int dk = dg * 8 + dd;
#pragma unroll
          for (int i = 0; i < 4; ++i) { pw[i] += S[dd] * wsm[i * 128 + dk]; pq[i] += S[dd] * qs[i * 128 + dk]; } }
#pragma unroll
      for (int i = 0; i < 4; ++i) { *(LAS f32x4*)(redp + (dg * 8 + i) * 128 + c4 * 4) = pw[i]; *(LAS f32x4*)(redp + (dg * 8 + 4 + i) * 128 + c4 * 4) = pq[i]; } }
    __syncthreads();
#pragma unroll
    for (int e = 0; e < 2; ++e) { const int idx = tid + e * 512; float s = 0.f;
#pragma unroll
        for (int g = 0; g < 16; ++g) s += redp[g * 1024 + idx];
        red[idx] = s; }
    __syncthreads();
    if (tid < 128) { const int dv = tid; float v[4];
#pragma unroll
        for (int i = 0; i < 4; ++i) { v[i] = us[i * 128 + dv] - red[i * 128 + dv]; vn[i * 128 + dv] = v[i]; }
#pragma unroll
        for (int i = 0; i < 4; ++i) { float o = __expf(Gs[i]) * red[(4 + i) * 128 + dv];
#pragma unroll
            for (int j = 0; j < 4; ++j) if (j <= i) o += qkd[i * 4 + j] * __expf(Gs[i] - Gs[j]) * v[j];
            on[i * 128 + dv] = o; } }
    __syncthreads();
    { float* Sout = P.out + O_GDNS + sbase; const float eg = __expf(Gs[3]); f32x4 vv[4];
#pragma unroll
      for (int j = 0; j < 4; ++j) vv[j] = *(LAS f32x4*)(vn + j * 128 + c4 * 4) * __expf(Gs[3] - Gs[j]);
#pragma unroll
      for (int dd = 0; dd < 8; ++dd) { const int dk = dg * 8 + dd; f32x4 sn = S[dd] * eg;
#pragma unroll
          for (int j = 0; j < 4; ++j) sn += vv[j] * ks[j * 128 + dk];
          *(f32x4*)(Sout + dd * 128) = sn; } }
    if (w < 4) { const int i = w; const float a = on[i * 128 + lane], c = on[i * 128 + lane + 64]; float ss = a * a + c * c;
#pragma unroll
        for (int o = 32; o >= 1; o >>= 1) ss += __shfl_xor(ss, o);
        const float rn = rsqrtf(ss * (1.f / 128.f) + EPS);
        const bf16_t* zp = proj + (row0 + i) * 6144 + 4096 + hvg * 128; bf16_t* op = og + (row0 + i) * 2048 + hvg * 128;
        op[lane] = f2bf(a * rn * P.in[21][lane] * silu_f(bf2f(zp[lane]))); op[lane + 64] = f2bf(c * rn * P.in[21][lane + 64] * silu_f(bf2f(zp[lane + 64]))); }
    __syncthreads();
}

__device__ void phase_gdn_prep(const Params& P, lds_t lds, int bid, int nb, int tid) {
    for (int t = bid; t < 2048; t += nb) gdn_prep_task(P, t, lds, tid);
}
__device__ void phase_gdn_scan(const Params& P, lds_t lds, int bid, int nb, int tid) {
    if (nb >= 256) {
        if (bid < 128) gdn_scan_task(P, bid, lds, tid);
        else for (int t = bid - 128; t < 2048; t += nb - 128) gdn_sample_task(P, t, lds, tid);
    } else {
        for (int t = bid; t < 128; t += nb) gdn_scan_task(P, t, lds, tid);
        for (int t = bid; t < 2048; t += nb) gdn_sample_task(P, t, lds, tid);
    }
}

#ifndef PHMASK
#define PHMASK 0x1fffffu
#endif
constexpr int NPH = 21;
__global__ void __launch_bounds__(512) fwd(Params P) {
    extern __shared__ __attribute__((aligned(16))) unsigned char lds_raw[];
    lds_t lds = (lds_t)lds_raw;
    cg::grid_group grid = cg::this_grid();
    const int bid = blockIdx.x, nb = gridDim.x, tid = threadIdx.x;
    unsigned char* ws = P.ws;
    const float* mod = (const float*)(ws + WS_MOD);
    bf16_t* H = (bf16_t*)(ws + WS_H); float* XA = (float*)(ws + WS_XA); float* XB = (float*)(ws + WS_XB);
    bf16_t* PROJ = (bf16_t*)(ws + WS_PROJ); bf16_t* OG = (bf16_t*)(ws + WS_OG);
    const int lo = P.ph_lo, hi = P.ph_hi;
#define SEAM(k) if ((k) + 1 < hi) grid.sync();
    if (lo <= 0 && 0 < hi) { if constexpr ((PHMASK >> 0) & 1u) { phase_prep(P, lds, bid, nb, tid); } SEAM(0) }
    if (lo <= 1 && 1 < hi) { if constexpr ((PHMASK >> 1) & 1u) { { pg8::EpiF32 E{(float*)(ws + WS_MOD), MODN, (const float*)(ws + WS_MODB)}; run_gemm(lds, (const bf16_t*)(ws + WS_CS), (const bf16_t*)(ws + WS_WT_ADA), 256, MODN, 1024, E, bid, nb); } } SEAM(1) }
    if (lo <= 2 && 2 < hi) { if constexpr ((PHMASK >> 2) & 1u) { phase_adaln(P, P.in[0], P.in[1], P.in[12], 0, 1024, H, nullptr, nullptr, bid, nb, tid); } SEAM(2) }
    if (lo <= 3 && 3 < hi) { if constexpr ((PHMASK >> 3) & 1u) { { pg8::EpiBf16<0> E{PROJ, 6144, nullptr, 0, 0}; run_gemm(lds, H, (const bf16_t*)(ws + WS_WT_RET_IN), MT, 6144, 1024, E, bid, nb); } } SEAM(3) }
    if (lo <= 4 && 4 < hi) { if constexpr ((PHMASK >> 4) & 1u) { phase_retention(P, lds, bid, nb, tid); } SEAM(4) }
    if (lo <= 5 && 5 < hi) { if constexpr ((PHMASK >> 5) & 1u) { phase_post_ret(P, bid, nb, tid); } SEAM(5) }
    if (lo <= 6 && 6 < hi) { if constexpr ((PHMASK >> 6) & 1u) { { EpiResid E{P.in[0], P.in[1], XA, mod + 2048}; run_gemm(lds, OG, (const bf16_t*)(ws + WS_WT_RET_OUT), MT, 1024, 2048, E, bid, nb); } } SEAM(6) }
    if (lo <= 7 && 7 < hi) { if constexpr ((PHMASK >> 7) & 1u) { phase_adaln(P, XA, XA + (size_t)MP * 1024, P.in[13], 3072, 4096, H, nullptr, nullptr, bid, nb, tid); } SEAM(7) }
    if (lo <= 8 && 8 < hi) { if constexpr ((PHMASK >> 8) & 1u) { { EpiUp E{(bf16_t*)(ws + WS_U), P.out + O_FCP, P.out + O_FCS}; run_gemm(lds, H, (const bf16_t*)(ws + WS_WT_UP), MT, 5632, 1024, E, bid, nb); } } SEAM(8) }
    if (lo <= 9 && 9 < hi) { if constexpr ((PHMASK >> 9) & 1u) { phase_act(P, 0, bid, nb, tid); } SEAM(9) }
    if (lo <= 10 && 10 < hi) { if constexpr ((PHMASK >> 10) & 1u) { { EpiResid E{XA, XA + (size_t)MP * 1024, XB, mod + 5120}; run_gemm(lds, (const bf16_t*)(ws + WS_ACT), (const bf16_t*)(ws + WS_WT_DOWN), MT, 1024, 2816, E, bid, nb); } } SEAM(10) }
    if (lo <= 11 && 11 < hi) { if constexpr ((PHMASK >> 11) & 1u) { phase_adaln(P, XB, XB + (size_t)MP * 1024, P.in[12] + 1024, 6144, 6144 + 1024, H, nullptr, nullptr, bid, nb, tid); } SEAM(11) }
    if (lo <= 12 && 12 < hi) { if constexpr ((PHMASK >> 12) & 1u) { { EpiGdnIn E{PROJ, (float*)(ws + WS_BA), P.out + O_GCP, P.out + O_GCS}; run_gemm(lds, H, (const bf16_t*)(ws + WS_WT_GDN_IN), MT, 6400, 1024, E, bid, nb); } } SEAM(12) }
    if (lo <= 13 && 13 < hi) { if constexpr ((PHMASK >> 13) & 1u) { phase_gdn_prep(P, lds, bid, nb, tid); } SEAM(13) }
    if (lo <= 14 && 14 < hi) { if constexpr ((PHMASK >> 14) & 1u) { phase_gdn_scan(P, lds, bid, nb, tid); } SEAM(14) }
    if (lo <= 15 && 15 < hi) { if constexpr ((PHMASK >> 15) & 1u) { { EpiResid E{XB, XB + (size_t)MP * 1024, XA, mod + 6144 + 2048}; run_gemm(lds, OG, (const bf16_t*)(ws + WS_WT_GDN_OUT), MT, 1024, 2048, E, bid, nb); } } SEAM(15) }
    if (lo <= 16 && 16 < hi) { if constexpr ((PHMASK >> 16) & 1u) { phase_adaln(P, XA, XA + (size_t)MP * 1024, P.in[13] + 1024, 6144 + 3072, 6144 + 4096, H, nullptr, nullptr, bid, nb, tid); } SEAM(16) }
    if (lo <= 17 && 17 < hi) { if constexpr ((PHMASK >> 17) & 1u) { { EpiUp E{(bf16_t*)(ws + WS_U), P.out + O_FCP + (size_t)8 * 2 * 2816, P.out + O_FCS + (size_t)128 * 2 * 2816}; run_gemm(lds, H, (const bf16_t*)(ws + WS_WT_UP) + (size_t)5632 * 1024, MT, 5632, 1024, E, bid, nb); } } SEAM(17) }
    if (lo <= 18 && 18 < hi) { if constexpr ((PHMASK >> 18) & 1u) { phase_act(P, 1, bid, nb, tid); } SEAM(18) }
    if (lo <= 19 && 19 < hi) { if constexpr ((PHMASK >> 19) & 1u) { { EpiResid E{XA, XA + (size_t)MP * 1024, XB, mod + 6144 + 5120}; run_gemm(lds, (const bf16_t*)(ws + WS_ACT), (const bf16_t*)(ws + WS_WT_DOWN) + (size_t)1024 * 2816, MT, 1024, 2816, E, bid, nb); } } SEAM(19) }
    if (lo <= 20 && 20 < hi) { if constexpr ((PHMASK >> 20) & 1u) { phase_adaln(P, XB, XB + (size_t)MP * 1024, P.in[14], 12288, 12288 + 1024, nullptr, P.out + O_YP, P.out + O_YS, bid, nb, tid); } SEAM(20) }
}

#ifndef ONE_LAUNCH
#define ONE_LAUNCH 0
#endif
extern "C" void kernel_launch(void* const* d_in, const int* in_sizes, int n_in, void* d_out, int out_size, void* d_ws, size_t ws_size, hipStream_t stream) {
    static int grid_blocks = 0;
    if (!grid_blocks) {
        int dev = 0, cus = 0, per_cu = 0;
        hipGetDevice(&dev);
        hipDeviceGetAttribute(&cus, hipDeviceAttributeMultiprocessorCount, dev);
        hipFuncSetAttribute((const void*)fwd, hipFuncAttributeMaxDynamicSharedMemorySize, LDS_BYTES);
        hipOccupancyMaxActiveBlocksPerMultiprocessor(&per_cu, (const void*)fwd, 512, LDS_BYTES);
        if (per_cu < 1) { fprintf(stderr, "occupancy query says %d blocks per CU\n", per_cu); per_cu = 1; }
        grid_blocks = cus;
        if (ws_size < WS_END) fprintf(stderr, "workspace too small: %zu < %zu\n", ws_size, (size_t)WS_END);
    }
    Params p{};
    for (int i = 0; i < 27; ++i) p.in[i] = (const float*)d_in[i];
    p.out = (float*)d_out; p.ws = (unsigned char*)d_ws;
#if ONE_LAUNCH
    p.ph_lo = 0; p.ph_hi = NPH;
    { void* args[] = {&p}; hipError_t e = hipLaunchCooperativeKernel((void*)fwd, dim3(grid_blocks), dim3(512), args, LDS_BYTES, stream);
      if (e != hipSuccess) fprintf(stderr, "cooperative launch failed: %s (grid %d)\n", hipGetErrorString(e), grid_blocks); }
#else
    for (int ph = 0; ph < NPH; ++ph) { p.ph_lo = ph; p.ph_hi = ph + 1; hipLaunchKernelGGL(fwd, dim3(grid_blocks), dim3(512), LDS_BYTES, stream, p); }
#endif
}
```

```cpp
#include <hip/hip_runtime.h>
#include <hip/hip_cooperative_groups.h>
#include <cstdio>
namespace cg = cooperative_groups;
namespace pg8 {
#define PG8_LAS __attribute__((address_space(3)))
typedef unsigned short bf16_t;
typedef short bf16x8 __attribute__((ext_vector_type(8)));
typedef float f32x4 __attribute__((ext_vector_type(4)));
typedef unsigned u32x4 __attribute__((ext_vector_type(4)));
constexpr int BM = 256, BK = 64, HALF = 128, HTB = HALF * BK * 2  , STAGE_BYTES = 8 * HTB, NXCD = 8, WGM = 8;

__host__ __device__ __forceinline__ int lds_byte(int r, int c) { const int st = (r >> 4) * 2 + (c >> 5), rr = r & 15, cc = c & 31, ob = rr * 64 + cc * 2; return st * 1024 + (ob ^ (((ob >> 9) & 1) << 5)); }
__host__ __device__ __forceinline__ void stage_rc(int b, int& R, int& C) { const int st = b / 1024, sb = b % 1024, swz = sb ^ (((sb >> 9) & 1) << 5); R = (st >> 1) * 16 + swz / 64; C = (st & 1) * 32 + (swz % 64) / 2; }
__host__ __device__ __forceinline__ int perm32(int rho) { const int n = rho >> 4, i = rho & 15; return 8 * (i >> 2) + 4 * n + (i & 3); }

struct Unit { int pm, pn; };
struct Gemm { const bf16_t* A; const bf16_t* Bt; int M, N, K; };

struct StaticOrder {
    int nM, nN, nwg, G, c;
    __host__ __device__ void init(int M, int N, int G_, int c_) { nM = M / BM; nN = N / BM; nwg = nM * nN; G = G_; c = c_; }
    __host__ __device__ bool next(int i, Unit& u) const {
        const long L = (long)i * G + c; if (L >= nwg) return false;
        int wgid = (int)L; { const int q = nwg / NXCD, r = nwg % NXCD, xcd = wgid % NXCD, off = wgid / NXCD; wgid = (xcd < r ? xcd * (q + 1) : r * (q + 1) + (xcd - r) * q) + off; }
        const int nig = WGM * nN, gid = wgid / nig, fm = gid * WGM, gsz = (nM - fm) < WGM ? (nM - fm) : WGM;
        u.pm = fm + ((wgid % nig) % gsz); u.pn = (wgid % nig) / gsz; return true;
    }
    __device__ __forceinline__ void a_ready(const Unit&) const {}
    __device__ __forceinline__ void done(const Unit&) const {}
};
struct CountedOrder : StaticOrder {
    const unsigned* ready; unsigned need; unsigned* tmo;
    __device__ __forceinline__ void a_ready(const Unit& u) const {
        if (threadIdx.x < 64) {
            const unsigned long long t0 = __builtin_amdgcn_s_memrealtime(); unsigned polls = 0;
            while ((unsigned)__builtin_amdgcn_readfirstlane(__hip_atomic_load(ready + 64 * u.pm, __ATOMIC_RELAXED, __HIP_MEMORY_SCOPE_AGENT)) < need) {
                if ((++polls & 255u) == 0u && __builtin_amdgcn_readfirstlane(__hip_atomic_load(tmo, __ATOMIC_RELAXED, __HIP_MEMORY_SCOPE_AGENT)) != 0u) break;
                if (__builtin_amdgcn_s_memrealtime() - t0 > 2000000ull) {
                    if (threadIdx.x == 0) { unsigned expect = 0u; __hip_atomic_compare_exchange_strong(tmo + 1, &expect, 0x600u | (unsigned)(u.pm & 0xff), __ATOMIC_RELAXED, __ATOMIC_RELAXED, __HIP_MEMORY_SCOPE_AGENT); __hip_atomic_store(tmo, 1u, __ATOMIC_RELAXED, __HIP_MEMORY_SCOPE_AGENT); }
                    break; }
                __builtin_amdgcn_s_sleep(2); }
            __builtin_amdgcn_fence(__ATOMIC_ACQUIRE, "agent");
            asm volatile("s_waitcnt vmcnt(0)" ::: "memory");
        }
#if !defined(BROKEN_HOOK_NO_BARRIER)
        asm volatile("" ::: "memory"); __builtin_amdgcn_s_barrier(); asm volatile("" ::: "memory");
#endif
    }
};

__device__ __forceinline__ unsigned cvt_pk_bf16(float lo, float hi) { unsigned r; asm volatile("v_cvt_pk_bf16_f32 %0, %1, %2" : "=v"(r) : "v"(lo), "v"(hi)); return r; }
typedef float f32x2 __attribute__((ext_vector_type(2)));
__device__ __forceinline__ f32x2 gelu_pk(f32x2 v) {
    const f32x2 av = __builtin_elementwise_abs(v), d = av * 0.2316418882f + 1.0f;
    f32x2 t; t.x = __builtin_amdgcn_rcpf(d.x); t.y = __builtin_amdgcn_rcpf(d.y);
    f32x2 q = t * 0.5307027145f + (-0.7265760135f); q = q * t + 0.7107068705f; q = q * t + (-0.142248368f); q = q * t + 0.127414796f; q = q * t;
    const f32x2 s = (v * v) * (-0.72134752044f);
    f32x2 e; e.x = __builtin_amdgcn_exp2f(s.x); e.y = __builtin_amdgcn_exp2f(s.y);
    const f32x2 m = v * (q * e), r = v - m;
    f32x2 o; o.x = v.x < 0.f ? m.x : r.x; o.y = v.y < 0.f ? m.y : r.y; return o;
}

struct EpiF32 {
    static constexpr bool PERM = false, AFTER_DRAIN = false;
    float* C; int ldc; const float* bias;
    __device__ __forceinline__ void operator()(const f32x4 (&acc)[2][2][4][2], const Unit& u, int wr, int wc, int fr, int fq) const {
        const int row0 = u.pm * BM + wr * 64 + fr, col0 = u.pn * BM + wc * 32 + 4 * fq;
        f32x4 bv[2][2];
#pragma unroll
        for (int bj = 0; bj < 2; ++bj)
#pragma unroll
            for (int n = 0; n < 2; ++n) bv[bj][n] = bias ? *(const f32x4*)(bias + col0 + bj * HALF + n * 16) : (f32x4){0.f, 0.f, 0.f, 0.f};
#pragma unroll
        for (int ai = 0; ai < 2; ++ai)
#pragma unroll
            for (int m = 0; m < 4; ++m) { float* rowp = C + (size_t)(row0 + ai * HALF + m * 16) * ldc + col0;
#pragma unroll
                for (int bj = 0; bj < 2; ++bj)
#pragma unroll
                    for (int n = 0; n < 2; ++n) *(f32x4*)(rowp + bj * HALF + n * 16) = acc[ai][bj][m][n] + bv[bj][n]; }
    }
};
template <int ACT  > struct EpiBf16 {
    static constexpr bool PERM = true, AFTER_DRAIN = false;
    bf16_t* O; int ldc; const float* bias; int split_cols; size_t split_stride;
    __device__ __forceinline__ void operator()(const f32x4 (&acc)[2][2][4][2], const Unit& u, int wr, int wc, int fr, int fq) const {
        const int row0 = u.pm * BM + wr * 64 + fr; int colt = u.pn * BM; bf16_t* base = O;
        if (split_cols) { const int t = colt / split_cols; base += (size_t)t * split_stride; colt -= t * split_cols; }
        const int col0 = colt + wc * 32 + 8 * fq, bcol0 = u.pn * BM + wc * 32 + 8 * fq;
        f32x4 bv[2][2];
#pragma unroll
        for (int bj = 0; bj < 2; ++bj)
#pragma unroll
            for (int n = 0; n < 2; ++n) bv[bj][n] = bias ? *(const f32x4*)(bias + bcol0 + bj * HALF + 4 * n) : (f32x4){0.f, 0.f, 0.f, 0.f};
#pragma unroll
        for (int ai = 0; ai < 2; ++ai)
#pragma unroll
            for (int m = 0; m < 4; ++m) { bf16_t* rowp = base + (size_t)(row0 + ai * HALF + m * 16) * ldc + col0;
#pragma unroll
                for (int bj = 0; bj < 2; ++bj) { f32x4 v0 = acc[ai][bj][m][0] + bv[bj][0], v1 = acc[ai][bj][m][1] + bv[bj][1];
                    if (ACT == 1) { f32x2 a = gelu_pk((f32x2){v0[0], v0[1]}), b = gelu_pk((f32x2){v0[2], v0[3]}), c = gelu_pk((f32x2){v1[0], v1[1]}), d = gelu_pk((f32x2){v1[2], v1[3]});
                        v0 = (f32x4){a.x, a.y, b.x, b.y}; v1 = (f32x4){c.x, c.y, d.x, d.y}; }
                    if (ACT == 2) {
#pragma unroll
                        for (int j = 0; j < 4; ++j) { v0[j] = 0.5f * v0[j] * (1.0f + erff(v0[j] * 0.70710678f)); v1[j] = 0.5f * v1[j] * (1.0f + erff(v1[j] * 0.70710678f)); } }
                    u32x4 w; w.x = cvt_pk_bf16(v0[0], v0[1]); w.y = cvt_pk_bf16(v0[2], v0[3]); w.z = cvt_pk_bf16(v1[0], v1[1]); w.w = cvt_pk_bf16(v1[2], v1[3]);
                    *(u32x4*)(rowp + bj * HALF) = w; } }
    }
};

struct PanelStats {
    unsigned* xbuf;
    unsigned* cnt;
    unsigned* tmo;
    int ntn; float eps;
    unsigned code;
    __device__ __forceinline__ bool run(const f32x4 (&v)[2][2][4][2], const Unit& u, int wr, int wc, int fr, int fq, PG8_LAS unsigned char* lds, int wid, int lane) const {
        typedef float f32x2v __attribute__((ext_vector_type(2)));
        PG8_LAS f32x2v* P = (PG8_LAS f32x2v*)lds;
        PG8_LAS f32x2v* S = (PG8_LAS f32x2v*)(lds + 8192);
        PG8_LAS unsigned* flag = (PG8_LAS unsigned*)(lds + 8192 + 2048);
#pragma unroll
        for (int ai = 0; ai < 2; ++ai)
#pragma unroll
            for (int m = 0; m < 4; ++m) {
                float s = 0.f;
#pragma unroll
                for (int bj = 0; bj < 2; ++bj)
#pragma unroll
                    for (int n = 0; n < 2; ++n) { const f32x4 x = v[ai][bj][m][n]; s += (x[0] + x[1]) + (x[2] + x[3]); }
                s += __shfl_xor(s, 16); s += __shfl_xor(s, 32);
                const float mw = s * (1.0f / 64.0f); float q = 0.f;
#pragma unroll
                for (int bj = 0; bj < 2; ++bj)
#pragma unroll
                    for (int n = 0; n < 2; ++n) { const f32x4 d = v[ai][bj][m][n] - mw; q += (d[0] * d[0] + d[1] * d[1]) + (d[2] * d[2] + d[3] * d[3]); }
                q += __shfl_xor(q, 16); q += __shfl_xor(q, 32);
                if (fq == 0) P[(ai * HALF + wr * 64 + m * 16 + fr) * 4 + wc] = (f32x2v){mw, q};
            }
        asm volatile("s_waitcnt lgkmcnt(0)" ::: "memory"); __builtin_amdgcn_s_barrier(); asm volatile("" ::: "memory");
#if defined(BROKEN_NO_WAIT)
        if (blockIdx.x >= 64) { const long long t0 = clock64(); while (clock64() - t0 < 60000) __builtin_amdgcn_s_sleep(8); }
#endif
        const int row = wid * 32 + (lane & 31);
        if (lane < 32) {
            const f32x2v a = P[row * 4 + 0], b = P[row * 4 + 1], c = P[row * 4 + 2], d = P[row * 4 + 3];
            const float mt = (a.x + b.x + c.x + d.x) * 0.25f;
            const float da = a.x - mt, db = b.x - mt, dc = c.x - mt, dd = d.x - mt;
            const float m2 = (a.y + b.y) + (c.y + d.y) + 64.0f * ((da * da + db * db) + (dc * dc + dd * dd));
            unsigned long long* slot = (unsigned long long*)xbuf + ((size_t)(u.pm * BM + row) * 4 + u.pn);
            __hip_atomic_store(slot, ((unsigned long long)__float_as_uint(m2) << 32) | __float_as_uint(mt), __ATOMIC_RELAXED, __HIP_MEMORY_SCOPE_AGENT);
        }
        asm volatile("s_waitcnt vmcnt(0)" ::: "memory");
        if (lane == 0) __hip_atomic_fetch_add(cnt + 64 * u.pm, 1u, __ATOMIC_RELAXED, __HIP_MEMORY_SCOPE_AGENT);
        if (wid == 0) {
            bool dead = false; const unsigned long long t0 = __builtin_amdgcn_s_memrealtime(); const unsigned want = 8u * (unsigned)ntn;
            for (;;) {
#if defined(BROKEN_NO_WAIT)
                break;
#endif
                if ((unsigned)__builtin_amdgcn_readfirstlane(__hip_atomic_load(cnt + 64 * u.pm, __ATOMIC_RELAXED, __HIP_MEMORY_SCOPE_AGENT)) >= want) break;
                if (__builtin_amdgcn_s_memrealtime() - t0 > 2000000ull) {
                    if (lane == 0) { unsigned expect = 0u; __hip_atomic_compare_exchange_strong(tmo + 1, &expect, code | (unsigned)(u.pm & 0xff), __ATOMIC_RELAXED, __ATOMIC_RELAXED, __HIP_MEMORY_SCOPE_AGENT);
                                     __hip_atomic_store(tmo, 1u, __ATOMIC_RELAXED, __HIP_MEMORY_SCOPE_AGENT); }
                    dead = true; break; }
                __builtin_amdgcn_s_sleep(2);
            }
            __builtin_amdgcn_fence(__ATOMIC_ACQUIRE, "agent");
            if (lane == 0) flag[0] = dead ? 1u : 0u;
        }
        asm volatile("s_waitcnt vmcnt(0) lgkmcnt(0)" ::: "memory"); __builtin_amdgcn_s_barrier(); asm volatile("" ::: "memory");
        const bool bad = flag[0] != 0u;
        if (lane < 32) {
            const unsigned long long* slot = (const unsigned long long*)xbuf + (size_t)(u.pm * BM + row) * 4; float mt[4], m2[4]; float ms = 0.f;
#pragma unroll
            for (int t = 0; t < 4; ++t) { if (t < ntn) { const unsigned long long w = __hip_atomic_load(slot + t, __ATOMIC_RELAXED, __HIP_MEMORY_SCOPE_AGENT); mt[t] = __uint_as_float((unsigned)w); m2[t] = __uint_as_float((unsigned)(w >> 32)); } else { mt[t] = 0.f; m2[t] = 0.f; } ms += mt[t]; }
            const float mean = ms / (float)ntn; float q = 0.f;
#pragma unroll
            for (int t = 0; t < 4; ++t) if (t < ntn) { const float dm = mt[t] - mean; q += m2[t] + 256.0f * dm * dm; }
            S[row] = (f32x2v){mean, 1.0f / sqrtf(q / (256.0f * (float)ntn) + eps)};
        }
        asm volatile("s_waitcnt lgkmcnt(0)" ::: "memory"); __builtin_amdgcn_s_barrier(); asm volatile("" ::: "memory");
        return bad;
    }
};
struct EpiLnRes {
    static constexpr bool PERM = false, AFTER_DRAIN = true;
    const float* base; float* out; int ldc; const float* bias; PanelStats st; unsigned poison;
    __device__ __forceinline__ void refuse(size_t i0, size_t stride, int M, int N) const { const float q = __builtin_nanf(""); for (size_t i = i0; i < (size_t)M * N; i += stride) out[(i / N) * ldc + i % N] = q;
        if (i0 == 0) { unsigned expect = 0u; __hip_atomic_compare_exchange_strong(st.tmo + 1, &expect, 0x7f0u, __ATOMIC_RELAXED, __ATOMIC_RELAXED, __HIP_MEMORY_SCOPE_AGENT); __hip_atomic_store(st.tmo, 1u, __ATOMIC_RELAXED, __HIP_MEMORY_SCOPE_AGENT); } }
    __device__ __forceinline__ void fused(f32x4 (&acc)[2][2][4][2], const Unit& u, int wr, int wc, int fr, int fq, PG8_LAS unsigned char* lds, int wid, int lane) const {
        typedef float f32x2v __attribute__((ext_vector_type(2)));
        const PG8_LAS f32x2v* S = (const PG8_LAS f32x2v*)(lds + 8192);
        const int col0 = u.pn * BM + wc * 32 + 4 * fq;
#pragma unroll
        for (int bj = 0; bj < 2; ++bj)
#pragma unroll
            for (int n = 0; n < 2; ++n) { const f32x4 bv = bias ? *(const f32x4*)(bias + col0 + bj * HALF + n * 16) : (f32x4){0.f, 0.f, 0.f, 0.f};
#pragma unroll
                for (int ai = 0; ai < 2; ++ai)
#pragma unroll
                    for (int m = 0; m < 4; ++m) acc[ai][bj][m][n] += bv; }
        const bool bad = st.run(acc, u, wr, wc, fr, fq, lds, wid, lane) || poison != 0u;
        const float qnan = __builtin_nanf("");
#pragma unroll
        for (int ai = 0; ai < 2; ++ai)
#pragma unroll
            for (int m = 0; m < 4; ++m) { const int r = ai * HALF + wr * 64 + m * 16 + fr; const f32x2v sr = S[r]; const size_t off = (size_t)(u.pm * BM + r) * ldc + col0;
#pragma unroll
                for (int bj = 0; bj < 2; ++bj)
#pragma unroll
                    for (int n = 0; n < 2; ++n) { const f32x4 bs = *(const f32x4*)(base + off + bj * HALF + n * 16); f32x4 o = bs + (acc[ai][bj][m][n] - sr.x) * sr.y;
                        if (bad) o = (f32x4){qnan, qnan, qnan, qnan}; *(f32x4*)(out + off + bj * HALF + n * 16) = o; }
                asm volatile("" ::: "memory"); }
    }
};
struct EpiLnResLn {
    static constexpr bool PERM = false, AFTER_DRAIN = true;
    const float* base; float* out; bf16_t* xn; int ldc; const float* bias; PanelStats st1, st2; unsigned poison;
    __device__ __forceinline__ void refuse(size_t i0, size_t stride, int M, int N) const { const float q = __builtin_nanf(""); for (size_t i = i0; i < (size_t)M * N; i += stride) { const size_t o = (i / N) * ldc + i % N; out[o] = q; xn[o] = (bf16_t)0x7fc0u; }
        if (i0 == 0) { unsigned expect = 0u; __hip_atomic_compare_exchange_strong(st1.tmo + 1, &expect, 0x7f0u, __ATOMIC_RELAXED, __ATOMIC_RELAXED, __HIP_MEMORY_SCOPE_AGENT); __hip_atomic_store(st1.tmo, 1u, __ATOMIC_RELAXED, __HIP_MEMORY_SCOPE_AGENT); } }
    __device__ __forceinline__ void fused(f32x4 (&acc)[2][2][4][2], const Unit& u, int wr, int wc, int fr, int fq, PG8_LAS unsigned char* lds, int wid, int lane) const {
        typedef float f32x2v __attribute__((ext_vector_type(2))); typedef unsigned u32x2v __attribute__((ext_vector_type(2)));
        const PG8_LAS f32x2v* S = (const PG8_LAS f32x2v*)(lds + 8192);
        const int col0 = u.pn * BM + wc * 32 + 4 * fq;
#pragma unroll
        for (int bj = 0; bj < 2; ++bj)
#pragma unroll
            for (int n = 0; n < 2; ++n) { const f32x4 bv = bias ? *(const f32x4*)(bias + col0 + bj * HALF + n * 16) : (f32x4){0.f, 0.f, 0.f, 0.f};
#pragma unroll
                for (int ai = 0; ai < 2; ++ai)
#pragma unroll
                    for (int m = 0; m < 4; ++m) acc[ai][bj][m][n] += bv; }
        bool bad = st1.run(acc, u, wr, wc, fr, fq, lds, wid, lane) || poison != 0u;
        const float qnan = __builtin_nanf("");
#pragma unroll
        for (int ai = 0; ai < 2; ++ai)
#pragma unroll
            for (int m = 0; m < 4; ++m) { const int r = ai * HALF + wr * 64 + m * 16 + fr; const f32x2v sr = S[r]; const size_t off = (size_t)(u.pm * BM + r) * ldc + col0;
#pragma unroll
                for (int bj = 0; bj < 2; ++bj)
#pragma unroll
                    for (int n = 0; n < 2; ++n) { const f32x4 bs = *(const f32x4*)(base + off + bj * HALF + n * 16); acc[ai][bj][m][n] = bs + (acc[ai][bj][m][n] - sr.x) * sr.y; }
                asm volatile("" : "+v"(acc[ai][0][m][0]), "+v"(acc[ai][0][m][1]), "+v"(acc[ai][1][m][0]), "+v"(acc[ai][1][m][1]));
                if (m & 1) asm volatile("" ::: "memory"); }
        const bool bad1 = bad;
        bad = st2.run(acc, u, wr, wc, fr, fq, lds, wid, lane) || bad;
#pragma unroll
        for (int ai = 0; ai < 2; ++ai)
#pragma unroll
            for (int m = 0; m < 4; ++m) { const int r = ai * HALF + wr * 64 + m * 16 + fr; const f32x2v sr = S[r]; const size_t off = (size_t)(u.pm * BM + r) * ldc + col0;
#pragma unroll
                for (int bj = 0; bj < 2; ++bj)
#pragma unroll
                    for (int n = 0; n < 2; ++n) { const f32x4 x1 = acc[ai][bj][m][n]; *(f32x4*)(out + off + bj * HALF + n * 16) = bad1 ? (f32x4){qnan, qnan, qnan, qnan} : x1;
                        const f32x4 o = (x1 - sr.x) * sr.y; u32x2v w; w.x = cvt_pk_bf16(o[0], o[1]); w.y = cvt_pk_bf16(o[2], o[3]);
                        if (bad) { w.x = 0x7fc07fc0u; w.y = 0x7fc07fc0u; } *(u32x2v*)(xn + off + bj * HALF + n * 16) = w; }
                asm volatile("" ::: "memory"); }
    }
};

template <class Epi, class Sched, bool STAMP = false>
__device__ __forceinline__ void gemm_phase(PG8_LAS unsigned char* lds, const Gemm g, const Sched& S, const Epi& E, unsigned long long* stamps) {
    const int tid = threadIdx.x, wid = __builtin_amdgcn_readfirstlane(tid >> 6), lane = tid & 63, wr = wid >> 2, wc = wid & 3, fr = lane & 15, fq = lane >> 4;
    const int K = g.K, nt = K / BK;
    int ts_lo = 0, ts_hi = 0, nts = 0; const unsigned long long rt_entry = STAMP ? (unsigned long long)wall_clock64() : 0ull;
#define PG8_STAMP() do { if (STAMP && wid == 0 && nts < 64) { const unsigned long long _c = (unsigned long long)clock64(); \
        ts_lo = (lane == nts) ? (int)(unsigned)_c : ts_lo; ts_hi = (lane == nts) ? (int)(unsigned)(_c >> 32) : ts_hi; ++nts; } } while (0)
    PG8_STAMP();
    unsigned voffA[2], voffB[2];
#pragma unroll
    for (int i = 0; i < 2; ++i) { int R, C; stage_rc(tid * 16 + i * 8192, R, C); const int Rb = Epi::PERM ? ((R & ~31) + perm32(R & 31)) : R;
        voffA[i] = (unsigned)(R * K + C) * 2u; voffB[i] = (unsigned)(Rb * K + C) * 2u; }
    const size_t kstep = (size_t)(BK * 2);
    const size_t hstep = (size_t)HALF * K * 2;
    const size_t tstep = 2 * hstep;
    const unsigned ldsw = (unsigned)wid * 1024u;
    const int aoff = lds_byte(wr * 64 + fr, fq * 8), boff = lds_byte(wc * 32 + fr, fq * 8);
#define PG8_SA(b, h) (((b) * 2 + (h)) * HTB)
#define PG8_SB(b, h) ((4 + (b) * 2 + (h)) * HTB)
#define PG8_STAGE(bufoff, gbase, voff) do { _Pragma("unroll") for (int _i = 0; _i < 2; ++_i) \
        __builtin_amdgcn_global_load_lds((const unsigned*)((const char*)(gbase) + (voff)[_i]), (PG8_LAS unsigned*)(lds + (bufoff) + ldsw + _i * 8192), 16, 0, 0); } while (0)
#define PG8_LDA(dst, b, h) do { _Pragma("unroll") for (int m = 0; m < 4; ++m) _Pragma("unroll") for (int k = 0; k < 2; ++k) dst[m][k] = *(const PG8_LAS bf16x8*)(lds + PG8_SA(b, h) + aoff + m * 2048 + k * 1024); } while (0)
#define PG8_LDB(dst, b, h) do { _Pragma("unroll") for (int n = 0; n < 2; ++n) _Pragma("unroll") for (int k = 0; k < 2; ++k) dst[n][k] = *(const PG8_LAS bf16x8*)(lds + PG8_SB(b, h) + boff + n * 2048 + k * 1024); } while (0)
#define PG8_MMA(ai, bj, At, Bt) do { __builtin_amdgcn_s_setprio(1); _Pragma("unroll") for (int m = 0; m < 4; ++m) _Pragma("unroll") for (int n = 0; n < 2; ++n) _Pragma("unroll") for (int k = 0; k < 2; ++k) \
        acc[ai][bj][m][n] = __builtin_amdgcn_mfma_f32_16x16x32_bf16(Bt[n][k], At[m][k], acc[ai][bj][m][n], 0, 0, 0); __builtin_amdgcn_s_setprio(0); } while (0)
#define PG8_WAIT_V(n) asm volatile("s_waitcnt vmcnt(" #n ")" ::: "memory")
#define PG8_WAIT_L(n) asm volatile("s_waitcnt lgkmcnt(" #n ")" ::: "memory")
#define PG8_BAR __builtin_amdgcn_s_barrier()
#define PG8_SCHED __builtin_amdgcn_sched_barrier(0)
    Unit cur, nxt; int ui = 0;
    if (!S.next(0, cur)) return;
    f32x4 acc[2][2][4][2];
#pragma unroll
    for (int a = 0; a < 2; ++a)
#pragma unroll
        for (int b = 0; b < 2; ++b)
#pragma unroll
            for (int m = 0; m < 4; ++m)
#pragma unroll
                for (int n = 0; n < 2; ++n) acc[a][b][m][n] = (f32x4){0.f, 0.f, 0.f, 0.f};
    bf16x8 At[4][2], B0[2][2], B1[2][2];
    const char* cA = (const char*)g.A + (size_t)cur.pm * tstep; const char* cB = (const char*)g.Bt + (size_t)cur.pn * tstep;
    S.a_ready(cur);
    PG8_STAGE(PG8_SB(0, 0), cB, voffB); PG8_STAGE(PG8_SA(0, 0), cA, voffA); PG8_STAGE(PG8_SB(0, 1), cB + hstep, voffB); PG8_STAGE(PG8_SA(0, 1), cA + hstep, voffA);
    if (wr == 1) PG8_BAR;
    PG8_WAIT_V(4); PG8_BAR;
    PG8_STAGE(PG8_SB(1, 0), cB + kstep, voffB); PG8_STAGE(PG8_SA(1, 0), cA + kstep, voffA); PG8_STAGE(PG8_SB(1, 1), cB + hstep + kstep, voffB);
    PG8_WAIT_V(6); PG8_BAR;
    PG8_STAMP();
    for (;;) {
        const bool has_next = S.next(ui + 1, nxt);
        const char* nA = has_next ? (const char*)g.A + (size_t)nxt.pm * tstep : cA; const char* nB = has_next ? (const char*)g.Bt + (size_t)nxt.pn * tstep : cB;
        for (int t = 0; t < nt; t += 2) {
            const bool last = (t == nt - 2);
            const char* a1 = cA + (size_t)(t + 1) * kstep;
            const char* a2 = last ? nA : cA + (size_t)(t + 2) * kstep; const char* b2 = last ? nB : cB + (size_t)(t + 2) * kstep;
            const char* a3 = a2 + kstep; const char* b3 = b2 + kstep;
            if (last && has_next) S.a_ready(nxt);
            PG8_LDB(B0, 0, 0); PG8_SCHED; PG8_LDA(At, 0, 0); PG8_STAGE(PG8_SA(1, 1), a1 + hstep, voffA);
            PG8_WAIT_L(8); PG8_BAR; PG8_WAIT_L(0); PG8_MMA(0, 0, At, B0); PG8_BAR; PG8_SCHED;
            PG8_LDB(B1, 0, 1); PG8_STAGE(PG8_SB(0, 0), b2, voffB);
            PG8_BAR; PG8_WAIT_L(0); PG8_MMA(0, 1, At, B1); PG8_BAR;
            PG8_LDA(At, 0, 1); PG8_STAGE(PG8_SA(0, 0), a2, voffA);
            PG8_BAR; PG8_WAIT_L(0); PG8_MMA(1, 0, At, B0); PG8_BAR; PG8_SCHED;
            PG8_STAGE(PG8_SB(0, 1), b2 + hstep, voffB);
            PG8_WAIT_V(6); PG8_BAR; PG8_MMA(1, 1, At, B1); PG8_BAR;
            PG8_LDB(B0, 1, 0); PG8_SCHED; PG8_LDA(At, 1, 0); PG8_STAGE(PG8_SA(0, 1), a2 + hstep, voffA);
            PG8_WAIT_L(8); PG8_BAR; PG8_WAIT_L(0); PG8_MMA(0, 0, At, B0); PG8_BAR; PG8_SCHED;
            PG8_LDB(B1, 1, 1); PG8_STAGE(PG8_SB(1, 0), b3, voffB);
            PG8_BAR; PG8_WAIT_L(0); PG8_MMA(0, 1, At, B1); PG8_BAR;
            PG8_LDA(At, 1, 1); PG8_STAGE(PG8_SA(1, 0), a3, voffA);
            PG8_BAR; PG8_WAIT_L(0); PG8_MMA(1, 0, At, B0); PG8_BAR; PG8_SCHED;
            PG8_STAGE(PG8_SB(1, 1), b3 + hstep, voffB);
            PG8_WAIT_V(6); PG8_BAR; PG8_MMA(1, 1, At, B1); PG8_BAR;
        }
        PG8_STAMP();
        if constexpr (!Epi::AFTER_DRAIN) { E(acc, cur, wr, wc, fr, fq); S.done(cur); }
        PG8_STAMP();
        if (!has_next) break;
#pragma unroll
        for (int a = 0; a < 2; ++a)
#pragma unroll
            for (int b = 0; b < 2; ++b)
#pragma unroll
                for (int m = 0; m < 4; ++m)
#pragma unroll
                    for (int n = 0; n < 2; ++n) acc[a][b][m][n] = (f32x4){0.f, 0.f, 0.f, 0.f};
        cur = nxt; cA = nA; cB = nB; ++ui;
    }
    PG8_WAIT_V(0);
    if (wr == 0) PG8_BAR;
    PG8_BAR;
    if constexpr (Epi::AFTER_DRAIN) { E.fused(acc, cur, wr, wc, fr, fq, lds, wid, lane); S.done(cur); }
    PG8_STAMP();
    if (STAMP && wid == 0) { stamps[lane] = lane < nts ? (((unsigned long long)(unsigned)ts_hi << 32) | (unsigned)ts_lo) : 0ull;
        if (lane == 62) stamps[62] = rt_entry; if (lane == 63) stamps[63] = (unsigned long long)wall_clock64(); }
#undef PG8_STAMP
#undef PG8_SA
#undef PG8_SB
#undef PG8_STAGE
#undef PG8_LDA
#undef PG8_LDB
#undef PG8_MMA
#undef PG8_WAIT_V
#undef PG8_WAIT_L
#undef PG8_BAR
#undef PG8_SCHED
}
}

using pg8::bf16_t; using pg8::bf16x8; using pg8::f32x4; using pg8::u32x4;
#define LAS __attribute__((address_space(3)))
typedef LAS unsigned char* lds_t;
typedef LAS bf16_t* lbf_t;
typedef LAS float* lf_t;
typedef unsigned u32x2 __attribute__((ext_vector_type(2)));

constexpr int MP = 16384, MSM = 512, MT = MP + MSM, MODN = 14336;
constexpr float EPS = 1e-6f;
constexpr size_t WS_WT_RET_IN = 0;
constexpr size_t WS_WT_RET_OUT = WS_WT_RET_IN + (size_t)6144 * 1024 * 2;
constexpr size_t WS_WT_GDN_IN = WS_WT_RET_OUT + (size_t)1024 * 2048 * 2;
constexpr size_t WS_WT_GDN_OUT = WS_WT_GDN_IN + (size_t)6400 * 1024 * 2;
constexpr size_t WS_WT_UP = WS_WT_GDN_OUT + (size_t)1024 * 2048 * 2;
constexpr size_t WS_WT_DOWN = WS_WT_UP + (size_t)2 * 5632 * 1024 * 2;
constexpr size_t WS_WT_ADA = WS_WT_DOWN + (size_t)2 * 1024 * 2816 * 2;
constexpr size_t WS_CS = WS_WT_ADA + (size_t)14336 * 1024 * 2;
constexpr size_t WS_MODB = WS_CS + (size_t)256 * 1024 * 2;
constexpr size_t WS_MOD = WS_MODB + (size_t)14336 * 4;
constexpr size_t WS_ROPE = WS_MOD + (size_t)256 * 14336 * 4;
constexpr size_t WS_XA = WS_ROPE + (size_t)2 * 2052 * 128 * 4;
constexpr size_t WS_XB = WS_XA + (size_t)MT * 1024 * 4;
constexpr size_t WS_H = WS_XB + (size_t)MT * 1024 * 4;
constexpr size_t WS_PROJ = WS_H + (size_t)MT * 1024 * 2;
constexpr size_t WS_BA = WS_PROJ + (size_t)MT * 6144 * 2;
constexpr size_t WS_OG = WS_BA + (size_t)MT * 32 * 4;
constexpr size_t WS_SSQ = WS_OG + (size_t)MT * 2048 * 2;
constexpr size_t WS_R2 = WS_SSQ + (size_t)MT * 64 * 4;
constexpr size_t GREC = 73728 + 256;
constexpr size_t WS_U = WS_R2;
constexpr size_t WS_ACT = WS_R2 + (size_t)MT * 5632 * 2;
constexpr size_t WS_ORAW = WS_R2;
constexpr size_t WS_CTL = WS_R2 + (size_t)4096 * GREC;
constexpr size_t WS_SIDEG = WS_CTL + 16384;
constexpr size_t WS_SIDEV = WS_SIDEG + (size_t)264 * 4 * 2816 * 4;
constexpr size_t WS_END = WS_SIDEV + (size_t)264 * 2 * 2816 * 4;
constexpr size_t O_YP = 0, O_YS = O_YP + (size_t)MP * 1024, O_RETP = O_YS + (size_t)MSM * 1024, O_GDNP = O_RETP + (size_t)8 * 4 * 256 * 512,
                 O_GCP = O_GDNP + (size_t)8 * 16 * 128 * 128, O_FCP = O_GCP + (size_t)8 * 3 * 4096, O_RETS = O_FCP + (size_t)2 * 8 * 2 * 2816,
                 O_GDNS = O_RETS + (size_t)128 * 4 * 256 * 512, O_GCS = O_GDNS + (size_t)128 * 16 * 128 * 128, O_FCS = O_GCS + (size_t)128 * 3 * 4096;
constexpr int LDS_BYTES = 160 * 1024;

struct Params { const float* in[27]; float* out; unsigned char* ws; int ph_lo, ph_hi, rep, pad; };

__device__ __forceinline__ float bf2f(bf16_t b) { return __uint_as_float(((unsigned)b) << 16); }
__device__ __forceinline__ float bflo(unsigned u) { return __uint_as_float(u << 16); }
__device__ __forceinline__ float bfhi(unsigned u) { return __uint_as_float(u & 0xffff0000u); }
typedef float f32x2_t __attribute__((ext_vector_type(2)));
typedef __bf16 bf16x2_t __attribute__((ext_vector_type(2)));
__device__ __forceinline__ unsigned pk2(float lo, float hi) { f32x2_t v = {lo, hi}; bf16x2_t b = __builtin_convertvector(v, bf16x2_t); return __builtin_bit_cast(unsigned, b); }
__device__ __forceinline__ bf16_t f2bf(float f) { return (bf16_t)(pk2(f, 0.f) & 0xffffu); }
__device__ __forceinline__ float silu_f(float x) { return x * __builtin_amdgcn_rcpf(1.f + __expf(-x)); }
__device__ __forceinline__ float sigmoid_f(float x) { return __builtin_amdgcn_rcpf(1.f + __expf(-x)); }
__device__ __forceinline__ void unpack8(const u32x4 v, float* f) { f[0] = bflo(v.x); f[1] = bfhi(v.x); f[2] = bflo(v.y); f[3] = bfhi(v.y); f[4] = bflo(v.z); f[5] = bfhi(v.z); f[6] = bflo(v.w); f[7] = bfhi(v.w); }
__device__ __forceinline__ u32x4 pack8(const float* f) { u32x4 v; v.x = pk2(f[0], f[1]); v.y = pk2(f[2], f[3]); v.z = pk2(f[4], f[5]); v.w = pk2(f[6], f[7]); return v; }

template <int KS> __device__ __forceinline__ void mma16(f32x4& acc, lbf_t X, int ldx, lbf_t Y, int ldy, int lane) {
    lbf_t xp = X + (lane & 15) * ldx + (lane >> 4) * 8;
    lbf_t yp = Y + (lane & 15) * ldy + (lane >> 4) * 8;
#pragma unroll
    for (int k = 0; k < KS; ++k) {
        const bf16x8 a = *(const LAS bf16x8*)(xp + k * 32);
        const bf16x8 b = *(const LAS bf16x8*)(yp + k * 32);
        acc = __builtin_amdgcn_mfma_f32_16x16x32_bf16(a, b, acc, 0, 0, 0);
    }
}

__device__ __forceinline__ void lds_sync() { asm volatile("s_waitcnt lgkmcnt(0)" ::: "memory"); __builtin_amdgcn_s_barrier(); asm volatile("" ::: "memory"); }
__device__ __forceinline__ int tsw(int row, int col) { return row * 72 + ((((col >> 3) ^ (row >> 3)) & 7) << 3) + (col & 7); }
template <int KS, bool XS, bool YS> __device__ __forceinline__ void mma16s(f32x4& acc, lbf_t X, int ldx, int xrow0, lbf_t Y, int ldy, int yrow0, int lane) {
    const int xr = xrow0 + (lane & 15), yr = yrow0 + (lane & 15), q4 = lane >> 4;
#pragma unroll
    for (int k = 0; k < KS; ++k) {
        const int c = k * 4 + q4;
        const bf16x8 a = *(const LAS bf16x8*)(X + xr * ldx + (XS ? ((c ^ (xr >> 3)) & 7) : c) * 8);
        const bf16x8 b = *(const LAS bf16x8*)(Y + yr * ldy + (YS ? ((c ^ (yr >> 3)) & 7) : c) * 8);
        acc = __builtin_amdgcn_mfma_f32_16x16x32_bf16(a, b, acc, 0, 0, 0);
    }
}

__device__ __forceinline__ bf16x8 ldf(lbf_t B, int ld, int row0, int kc, int lane) { return *(const LAS bf16x8*)(B + (row0 + (lane & 15)) * ld + (kc * 4 + (lane >> 4)) * 8); }
__device__ __forceinline__ bf16x8 ldfs(lbf_t B, int row0, int kc, int lane) { const int r = row0 + (lane & 15), c = kc * 4 + (lane >> 4); return *(const LAS bf16x8*)(B + r * 72 + ((c ^ (r >> 3)) & 7) * 8); }
#define MF(acc, a, b) acc = __builtin_amdgcn_mfma_f32_16x16x32_bf16(a, b, acc, 0, 0, 0)

template <bool GV = false> __device__ __forceinline__ void transpose_convert(const float* __restrict__ src, int K, int N, bf16_t* __restrict__ dst, int Npad, lds_t lds, int bid, int nb, int tid) {
    lf_t tl = (lf_t)lds;
    const int nTn = Npad / 128, ntiles = (K / 64) * nTn;
    f32x4 pa[4], pb[4];
#define TC_LOAD(pv, tile_) do { const int k0_ = ((tile_) / nTn) * 64, nt_ = (tile_) % nTn, n0_ = GV ? ((nt_ & 1) ? 2816 + (nt_ >> 1) * 128 : (nt_ >> 1) * 128) : nt_ * 128; _Pragma("unroll") for (int e = 0; e < 4; ++e) { const int kk = (tid >> 5) + e * 16, nn = (tid & 31) * 4; \
        pv[e] = (f32x4){0.f, 0.f, 0.f, 0.f}; if (n0_ + nn < N) pv[e] = __builtin_nontemporal_load((const f32x4*)(src + (size_t)(k0_ + kk) * N + n0_ + nn)); } } while (0)
#define TC_TILE(pv, tile) do { const int k0 = ((tile) / nTn) * 64, n0 = ((tile) % nTn) * 128; \
        _Pragma("unroll") for (int e = 0; e < 4; ++e) { const int kk = (tid >> 5) + e * 16, nn = (tid & 31) * 4; const f32x4 v = pv[e]; \
            tl[kk * 129 + nn] = v[0]; tl[kk * 129 + nn + 1] = v[1]; tl[kk * 129 + nn + 2] = v[2]; tl[kk * 129 + nn + 3] = v[3]; } \
        __syncthreads(); \
        if ((tile) + 2 * nb < ntiles) TC_LOAD(pv, (tile) + 2 * nb); \
        _Pragma("unroll") for (int e = 0; e < 2; ++e) { const int n = (tid >> 3) + e * 64, kc = (tid & 7) * 8; float f[8]; \
            _Pragma("unroll") for (int j = 0; j < 8; ++j) f[j] = tl[(kc + j) * 129 + n]; \
            *(u32x4*)(dst + (size_t)(n0 + n) * K + k0 + kc) = pack8(f); } \
        __syncthreads(); } while (0)
    if (bid < ntiles) TC_LOAD(pa, bid);
    if (bid + nb < ntiles) TC_LOAD(pb, bid + nb);
    for (int tile = bid; tile < ntiles; tile += 2 * nb) {
        TC_TILE(pa, tile);
        if (tile + nb < ntiles) TC_TILE(pb, tile + nb);
    }
#undef TC_TILE
#undef TC_LOAD
}

__device__ __forceinline__ void phase_prep_b(const Params& P, lds_t lds, int bid, int nb, int tid) {
    unsigned char* ws = P.ws;
    transpose_convert(P.in[15], 1024, 6144, (bf16_t*)(ws + WS_WT_RET_IN), 6144, lds, bid, nb, tid);
    transpose_convert(P.in[16], 2048, 1024, (bf16_t*)(ws + WS_WT_RET_OUT), 1024, lds, bid, nb, tid);
    transpose_convert<true>(P.in[23], 1024, 5632, (bf16_t*)(ws + WS_WT_UP), 5632, lds, bid, nb, tid);
}
__device__ __forceinline__ void phase_prep_c(const Params& P, lds_t lds, int bid, int nb, int tid) {
    unsigned char* ws = P.ws;
    transpose_convert(P.in[17], 1024, 6176, (bf16_t*)(ws + WS_WT_GDN_IN), 6400, lds, bid, nb, tid);
    transpose_convert<true>(P.in[23] + (size_t)1024 * 5632, 1024, 5632, (bf16_t*)(ws + WS_WT_UP) + (size_t)5632 * 1024, 5632, lds, bid, nb, tid);
}
__device__ __forceinline__ void phase_prep_d(const Params& P, lds_t lds, int bid, int nb, int tid) {
    unsigned char* ws = P.ws;
    transpose_convert(P.in[26], 2816, 1024, (bf16_t*)(ws + WS_WT_DOWN), 1024, lds, bid, nb, tid);
    transpose_convert(P.in[22], 2048, 1024, (bf16_t*)(ws + WS_WT_GDN_OUT), 1024, lds, bid, nb, tid);
    transpose_convert(P.in[26] + (size_t)2816 * 1024, 2816, 1024, (bf16_t*)(ws + WS_WT_DOWN) + (size_t)1024 * 2816, 1024, lds, bid, nb, tid);
}
__device__ __forceinline__ void phase_prep(const Params& P, lds_t lds, int bid, int nb, int tid) {
    unsigned char* ws = P.ws;
    transpose_convert(P.in[8], 1024, 6144, (bf16_t*)(ws + WS_WT_ADA), 6144, lds, bid, nb, tid);
    transpose_convert(P.in[8] + (size_t)1024 * 6144, 1024, 6144, (bf16_t*)(ws + WS_WT_ADA) + (size_t)6144 * 1024, 6144, lds, bid, nb, tid);
    transpose_convert(P.in[10], 1024, 2048, (bf16_t*)(ws + WS_WT_ADA) + (size_t)12288 * 1024, 2048, lds, bid, nb, tid);
    const int gt = bid * 512 + tid, gs = nb * 512;
    bf16_t* cs = (bf16_t*)(ws + WS_CS);
    for (int i = gt; i < 256 * 1024; i += gs) {
        const int r = i >> 10, c = i & 1023; float v = 0.f;
        if (r < 8) v = silu_f(P.in[6][r * 1024 + c]); else if (r < 136) v = silu_f(P.in[7][(r - 8) * 1024 + c]);
        cs[i] = f2bf(v);
    }
    float* modb = (float*)(ws + WS_MODB);
    for (int i = gt; i < MODN; i += gs) modb[i] = i < 12288 ? P.in[9][i] : P.in[11][i - 12288];
    float* rc = (float*)(ws + WS_ROPE); float* rs = rc + 2052 * 128;
    for (int i = gt; i < 2052 * 128; i += gs) {
        const int p = i >> 7, j = i & 127; const double pos = p < 2048 ? (double)p : (double)(16384 + p - 2048);
        const double inv = exp2(-(double)j * (13.287712379549449 / 128.0));
        double s, c; sincos(pos * inv, &s, &c); rc[i] = (float)c; rs[i] = (float)s;
    }
}

__device__ __forceinline__ void phase_adaln(const Params& P, const float* xp, const float* xs, const float* gw, int sh_off, int sc_off, bf16_t* h, float* yp, float* ys, int bid, int nb, int tid) {
    const float* mod = (const float*)(P.ws + WS_MOD);
    const int lane = tid & 63, w = tid >> 6;
    for (int row2 = bid * 32 + w * 4; row2 < MT; row2 += nb * 32)
#pragma unroll
    for (int rr = 0; rr < 4; ++rr) { const int row = row2 + rr;
        const float* x = row < MP ? xp + (size_t)row * 1024 : xs + (size_t)(row - MP) * 1024;
        const int seq = row < MP ? (row >> 11) : 8 + ((row - MP) >> 2);
        f32x4 v[4]; float ss = 0.f;
#pragma unroll
        for (int i = 0; i < 4; ++i) { v[i] = *(const f32x4*)(x + i * 256 + lane * 4); ss += v[i][0] * v[i][0] + v[i][1] * v[i][1] + v[i][2] * v[i][2] + v[i][3] * v[i][3]; }
#pragma unroll
        for (int o = 32; o >= 1; o >>= 1) ss += __shfl_xor(ss, o);
        const float r = rsqrtf(ss * (1.f / 1024.f) + EPS);
        const float* shp = mod + (size_t)seq * MODN + sh_off; const float* scp = mod + (size_t)seq * MODN + sc_off;
#pragma unroll
        for (int i = 0; i < 4; ++i) {
            const int c = i * 256 + lane * 4;
            const f32x4 g = *(const f32x4*)(gw + c), sh = *(const f32x4*)(shp + c), sc = *(const f32x4*)(scp + c);
            f32x4 o = v[i] * r * g * (sc + 1.f) + sh;
            if (h) { u32x2 pkd; pkd.x = pk2(o[0], o[1]); pkd.y = pk2(o[2], o[3]); *(u32x2*)(h + (size_t)row * 1024 + c) = pkd; }
            else { float* y = row < MP ? yp + (size_t)row * 1024 : ys + (size_t)(row - MP) * 1024; __builtin_nontemporal_store(o, (f32x4*)(y + c)); }
        }
    }
}

struct EpiResid {
    static constexpr bool PERM = false, AFTER_DRAIN = false;
    const float* bp; const float* bs; float* out; const float* gate;
    __device__ __forceinline__ void operator()(const f32x4 (&acc)[2][2][4][2], const pg8::Unit& u, int wr, int wc, int fr, int fq) const {
        const int row0 = u.pm * 256 + wr * 64 + fr, col0 = u.pn * 256 + wc * 32 + 4 * fq;
        const int seq = (u.pm * 256) >> 11;
        const float* gp = gate + (size_t)seq * MODN + col0;
        f32x4 g[2][2];
#pragma unroll
        for (int bj = 0; bj < 2; ++bj)
#pragma unroll
            for (int n = 0; n < 2; ++n) g[bj][n] = *(const f32x4*)(gp + bj * 128 + n * 16);
#pragma unroll
        for (int ai = 0; ai < 2; ++ai) {
            f32x4 b[4][2][2];
#pragma unroll
            for (int m = 0; m < 4; ++m)
#pragma unroll
                for (int bj = 0; bj < 2; ++bj)
#pragma unroll
                    for (int n = 0; n < 2; ++n) b[m][bj][n] = *(const f32x4*)(bp + (size_t)(row0 + ai * 128 + m * 16) * 1024 + col0 + bj * 128 + n * 16);
#pragma unroll
            for (int m = 0; m < 4; ++m)
#pragma unroll
                for (int bj = 0; bj < 2; ++bj)
#pragma unroll
                    for (int n = 0; n < 2; ++n) *(f32x4*)(out + (size_t)(row0 + ai * 128 + m * 16) * 1024 + col0 + bj * 128 + n * 16) = b[m][bj][n] + g[bj][n] * acc[ai][bj][m][n];
        }
    }
};
__device__ __forceinline__ float dpp_ror1(float x) { return __int_as_float(__builtin_amdgcn_update_dpp(0, __float_as_int(x), 0x121, 0xf, 0xf, false)); }
__device__ __forceinline__ float dpp_ror2(float x) { return __int_as_float(__builtin_amdgcn_update_dpp(0, __float_as_int(x), 0x122, 0xf, 0xf, false)); }
struct EpiUp {
    static constexpr bool PERM = true, AFTER_DRAIN = false;
    bf16_t* U; float* fcp; float* fcs; bf16_t* act; float* sideg; float* sidev; const float* wdw; const float* bdw;
    __device__ __forceinline__ void operator()(const f32x4 (&acc)[2][2][4][2], const pg8::Unit& u, int wr, int wc, int fr, int fq) const {
        const int row0 = u.pm * 256 + wr * 64 + fr, f0 = u.pn * 128 + wc * 32 + 8 * fq;
        if (u.pm >= 64) {
            const int col0 = u.pn * 256 + wc * 32 + 8 * fq;
#pragma unroll
            for (int ai = 0; ai < 2; ++ai)
#pragma unroll
                for (int m = 0; m < 4; ++m) { const int row = row0 + ai * 128 + m * 16, rs = row - MP, t = rs & 3; float* cp = (t >= 2) ? fcs + (size_t)((rs >> 2) * 2 + (t - 2)) * 2816 : nullptr;
#pragma unroll
                    for (int bj = 0; bj < 2; ++bj) { const f32x4 v0 = acc[ai][bj][m][0], v1 = acc[ai][bj][m][1];
                        u32x4 w; w.x = pk2(v0[0], v0[1]); w.y = pk2(v0[2], v0[3]); w.z = pk2(v1[0], v1[1]); w.w = pk2(v1[2], v1[3]);
                        *(u32x4*)(U + (size_t)row * 5632 + col0 + bj * 128) = w;
                        if (cp && bj == 0) { *(f32x4*)(cp + f0) = v0; *(f32x4*)(cp + f0 + 4) = v1; } } }
            return;
        }
        float w0[8], w1[8], w2[8], bb[8];
#pragma unroll
        for (int k = 0; k < 8; ++k) { w0[k] = wdw[f0 + k]; w1[k] = wdw[2816 + f0 + k]; w2[k] = wdw[2 * 2816 + f0 + k]; bb[k] = bdw[f0 + k]; }
#pragma unroll
        for (int ai = 0; ai < 2; ++ai) {
            const int seg = u.pm * 4 + ai * 2 + wr;
#pragma unroll
            for (int m = 0; m < 4; ++m) {
                const int row = row0 + ai * 128 + m * 16, t = row & 2047;
                float g0[8], gp[8], vv[8], o[8];
#pragma unroll
                for (int k = 0; k < 8; ++k) { g0[k] = acc[ai][0][m][k >> 2][k & 3]; vv[k] = acc[ai][1][m][k >> 2][k & 3]; gp[k] = (m > 0) ? acc[ai][0][m > 0 ? m - 1 : 0][k >> 2][k & 3] : 0.f; }
#pragma unroll
                for (int k = 0; k < 8; ++k) {
                    const float a1 = dpp_ror1(g0[k]), b1 = dpp_ror1(gp[k]), a2 = dpp_ror2(g0[k]), b2 = dpp_ror2(gp[k]);
                    const float g1 = fr >= 1 ? a1 : b1, g2 = fr >= 2 ? a2 : b2;
                    o[k] = silu_f(w0[k] * g2 + w1[k] * g1 + w2[k] * g0[k] + bb[k]) * vv[k];
                }
                if (m > 0 || fr >= 2) *(u32x4*)(act + (size_t)row * 2816 + f0) = pack8(o);
                if (m == 0 && fr < 2) { float* sg = sideg + ((size_t)seg * 4 + fr) * 2816 + f0; float* sv = sidev + ((size_t)seg * 2 + fr) * 2816 + f0;
                    *(f32x4*)sg = acc[ai][0][0][0]; *(f32x4*)(sg + 4) = acc[ai][0][0][1]; *(f32x4*)sv = acc[ai][1][0][0]; *(f32x4*)(sv + 4) = acc[ai][1][0][1]; }
                if (m == 3 && fr >= 14) { float* sg = sideg + ((size_t)seg * 4 + 2 + (fr - 14)) * 2816 + f0; *(f32x4*)sg = acc[ai][0][3][0]; *(f32x4*)(sg + 4) = acc[ai][0][3][1]; }
                if (t >= 2046) { float* cp = fcp + (size_t)((row >> 11) * 2 + (t - 2046)) * 2816 + f0; *(f32x4*)cp = acc[ai][0][m][0]; *(f32x4*)(cp + 4) = acc[ai][0][m][1]; }
            }
        }
    }
};
struct EpiGdnIn {
    static constexpr bool PERM = true, AFTER_DRAIN = false;
    bf16_t* proj; float* ba; float* gcp; float* gcs;
    __device__ __forceinline__ void operator()(const f32x4 (&acc)[2][2][4][2], const pg8::Unit& u, int wr, int wc, int fr, int fq) const {
        const int row0 = u.pm * 256 + wr * 64 + fr, col0 = u.pn * 256 + wc * 32 + 8 * fq;
#pragma unroll
        for (int ai = 0; ai < 2; ++ai)
#pragma unroll
            for (int m = 0; m < 4; ++m) {
                const int row = row0 + ai * 128 + m * 16; float* cp = nullptr;
                if (row < MP) { const int t = row & 2047; if (t >= 2045) cp = gcp + (size_t)((row >> 11) * 3 + (t - 2045)) * 4096; }
                else { const int rs = row - MP, t = rs & 3; if (t >= 1) cp = gcs + (size_t)((rs >> 2) * 3 + (t - 1)) * 4096; }
#pragma unroll
                for (int bj = 0; bj < 2; ++bj) { const int c = col0 + bj * 128; const f32x4 v0 = acc[ai][bj][m][0], v1 = acc[ai][bj][m][1];
                    if (c < 6144) {
                        u32x4 w; w.x = pk2(v0[0], v0[1]); w.y = pk2(v0[2], v0[3]); w.z = pk2(v1[0], v1[1]); w.w = pk2(v1[2], v1[3]);
                        *(u32x4*)(proj + (size_t)row * 6144 + c) = w;
                        if (cp && c < 4096) { *(f32x4*)(cp + c) = v0; *(f32x4*)(cp + c + 4) = v1; }
                    } else if (c < 6176) { float* bp = ba + (size_t)row * 32 + (c - 6144); *(f32x4*)bp = v0; *(f32x4*)(bp + 4) = v1; } }
            }
    }
};

template <int K> __device__ __forceinline__ void resid_sample_pieces(const bf16_t* A, const bf16_t* Bt, const EpiResid& E, lds_t lds, int bid, int nb, int tid) {
    const int lane = tid & 63, w = tid >> 6, l16 = lane & 15, q4 = lane >> 4;
    constexpr int KS = K / 32 / 8;
    LAS f32x4* red = (LAS f32x4*)lds;
    for (int p = bid; p < 256; p += nb) {
        const int r0 = MP + (p >> 3) * 16, ng0 = (p & 7) * 128;
        const bf16_t* ap = A + (size_t)(r0 + l16) * K + w * (KS * 32) + q4 * 8; const bf16_t* bp = Bt + (size_t)(ng0 + l16) * K + w * (KS * 32) + q4 * 8;
        f32x4 acc[8];
#pragma unroll
        for (int cb = 0; cb < 8; ++cb) acc[cb] = (f32x4){0.f, 0.f, 0.f, 0.f};
#pragma unroll 4
        for (int ks = 0; ks < KS; ++ks) { const bf16x8 a = *(const bf16x8*)(ap + ks * 32);
#pragma unroll
            for (int cb = 0; cb < 8; ++cb) { const bf16x8 b = *(const bf16x8*)(bp + (size_t)cb * 16 * K + ks * 32); acc[cb] = __builtin_amdgcn_mfma_f32_16x16x32_bf16(b, a, acc[cb], 0, 0, 0); } }
#pragma unroll
        for (int cb = 0; cb < 8; ++cb) red[(w * 8 + cb) * 64 + lane] = acc[cb];
        __syncthreads();
        f32x4 t = red[(0 * 8 + w) * 64 + lane];
#pragma unroll
        for (int k = 1; k < 8; ++k) t += red[(k * 8 + w) * 64 + lane];
        const int row = r0 + l16, c = ng0 + w * 16 + 4 * q4, seq = 8 + ((row - MP) >> 2);
        const float* base = E.bs + (size_t)(row - MP) * 1024;
        *(f32x4*)(E.out + (size_t)row * 1024 + c) = *(const f32x4*)(base + c) + *(const f32x4*)(E.gate + (size_t)seq * MODN + c) * t;
        __syncthreads();
    }
}
struct EpiNull { static constexpr bool PERM = false, AFTER_DRAIN = false;
    float* sink;
    __device__ __forceinline__ void operator()(const f32x4 (&acc)[2][2][4][2], const pg8::Unit& u, int wr, int wc, int fr, int fq) const {
        float s = 0.f;
#pragma unroll
        for (int ai = 0; ai < 2; ++ai)
#pragma unroll
            for (int bj = 0; bj < 2; ++bj)
#pragma unroll
                for (int m = 0; m < 4; ++m)
#pragma unroll
                    for (int n = 0; n < 2; ++n) s += acc[ai][bj][m][n][0] + acc[ai][bj][m][n][1] + acc[ai][bj][m][n][2] + acc[ai][bj][m][n][3];
        if (s == 1.2345e30f) sink[0] = s;
    }
};
template <class Epi> __device__ __forceinline__ void run_gemm(lds_t lds, const bf16_t* A, const bf16_t* Bt, int M, int N, int K, const Epi& E, int bid, int nb) {
    pg8::Gemm g{A, Bt, M, N, K}; pg8::StaticOrder S; S.init(M, N, nb, bid);
    pg8::gemm_phase<Epi, pg8::StaticOrder, false>(lds, g, S, E, nullptr);
    __syncthreads();
}

__device__ __forceinline__ void phase_post_ret(const Params& P, int bid, int nb, int tid) {
    const bf16_t* oraw = (const bf16_t*)(P.ws + WS_ORAW); const bf16_t* proj = (const bf16_t*)(P.ws + WS_PROJ);
    const float* ssq = (const float*)(P.ws + WS_SSQ); bf16_t* og = (bf16_t*)(P.ws + WS_OG);
    for (int u = bid * 512 + tid; u < MT * 256; u += nb * 512) {
        const int row = u >> 8, col = (u & 255) * 8, h = col >> 9;
        const f32x4* sp = (const f32x4*)(ssq + (size_t)row * 64 + h * 16);
        const f32x4 s0 = sp[0], s1 = sp[1], s2 = sp[2], s3 = sp[3];
        const float ss = (s0[0] + s0[1] + s0[2] + s0[3]) + (s1[0] + s1[1] + s1[2] + s1[3]) + (s2[0] + s2[1] + s2[2] + s2[3]) + (s3[0] + s3[1] + s3[2] + s3[3]);
        const float r = rsqrtf(ss * (1.f / 512.f) + EPS);
        float o[8], g[8];
        unpack8(*(const u32x4*)(oraw + (size_t)row * 2048 + col), o); unpack8(*(const u32x4*)(proj + (size_t)row * 6144 + 4096 + col), g);
#pragma unroll
        for (int j = 0; j < 8; ++j) o[j] = o[j] * r * silu_f(g[j]);
        *(u32x4*)(og + (size_t)row * 2048 + col) = pack8(o);
    }
}
__device__ __forceinline__ void phase_act(const Params& P, int l, int bid, int nb, int tid) {
    const bf16_t* U = (const bf16_t*)(P.ws + WS_U); bf16_t* act = (bf16_t*)(P.ws + WS_ACT);
    const float* sideg = (const float*)(P.ws + WS_SIDEG); const float* sidev = (const float*)(P.ws + WS_SIDEV);
    const float* wdw = P.in[24] + (size_t)l * 3 * 2816; const float* bdw = P.in[25] + (size_t)l * 2816;
    for (int u = bid * 512 + tid; u < 256 * 2 * 352; u += nb * 512) {
        const int f = (u % 352) * 8, rr = (u / 352) & 1, seg = u / 704, row = seg * 64 + rr, t = row & 2047;
        float g0[8], g1[8], g2[8], vv[8], o[8];
        const float* sg = sideg + (size_t)seg * 4 * 2816 + f;
#pragma unroll
        for (int k = 0; k < 8; ++k) { g0[k] = sg[rr * 2816 + k]; vv[k] = sidev[((size_t)seg * 2 + rr) * 2816 + f + k]; g1[k] = 0.f; g2[k] = 0.f; }
        if (rr == 1) {
#pragma unroll
            for (int k = 0; k < 8; ++k) g1[k] = sg[k];
            if (t >= 2) {
#pragma unroll
                for (int k = 0; k < 8; ++k) g2[k] = sg[-4 * 2816 + 3 * 2816 + k]; }
        } else if (t >= 2) {
#pragma unroll
            for (int k = 0; k < 8; ++k) { g1[k] = sg[-4 * 2816 + 3 * 2816 + k]; g2[k] = sg[-4 * 2816 + 2 * 2816 + k]; }
        }
#pragma unroll
        for (int k = 0; k < 8; ++k) o[k] = silu_f(wdw[f + k] * g2[k] + wdw[2816 + f + k] * g1[k] + wdw[2 * 2816 + f + k] * g0[k] + bdw[f + k]) * vv[k];
        *(u32x4*)(act + (size_t)row * 2816 + f) = pack8(o);
    }
    for (int u = MP * 352 + bid * 512 + tid; u < MT * 352; u += nb * 512) {
        const int row = u / 352, f = (u - row * 352) * 8, uc = (f >> 7) * 256 + (f & 127);
        float g0[8], g1[8], g2[8], vv[8];
        const bf16_t* up = U + (size_t)row * 5632 + uc;
        unpack8(*(const u32x4*)up, g0); unpack8(*(const u32x4*)(up + 128), vv);
        {
            const int rs = row - MP, t = rs & 3, b = rs >> 2;
            const float* buf = P.in[5] + (size_t)((l * 128 + b) * 2) * 2816 + f;
            if (t >= 1) unpack8(*(const u32x4*)(up - 5632), g1); else { for (int j = 0; j < 8; ++j) g1[j] = buf[2816 + j]; }
            if (t >= 2) unpack8(*(const u32x4*)(up - 2 * 5632), g2); else { for (int j = 0; j < 8; ++j) g2[j] = buf[t * 2816 + j]; }
        }
        float o[8];
#pragma unroll
        for (int j = 0; j < 8; ++j) { const float cv = wdw[f + j] * g2[j] + wdw[2816 + f + j] * g1[j] + wdw[2 * 2816 + f + j] * g0[j] + bdw[f + j]; o[j] = silu_f(cv) * vv[j]; }
        *(u32x4*)(act + (size_t)row * 2816 + f) = pack8(o);
    }
}

__device__ __forceinline__ void ret_prompt_task(const Params& P, int task, lds_t lds, int tid) {
    asm volatile("" : "+v"(tid));
    const int ph = ((task >> 6) << 3) + (task & 7), sl = (task >> 3) & 7, b = ph >> 2, h = ph & 3;
    const int lane = tid & 63, w = tid >> 6, q4 = lane >> 4, l16 = lane & 15;
    const bf16_t* proj = (const bf16_t*)(P.ws + WS_PROJ);
    const float* ropec = (const float*)(P.ws + WS_ROPE); const float* ropes = ropec + 2052 * 128;
    bf16_t* oraw = (bf16_t*)(P.ws + WS_ORAW); float* ssq = (float*)(P.ws + WS_SSQ);
    lbf_t Qs = (lbf_t)lds, Ks = Qs + 64 * 264, KdT = Ks + 64 * 264, VT = KdT + 256 * 72, Ps = VT + 64 * 72, ST = Ps + 64 * 72;
    const float lg2 = log2f(1.0f - exp2f(-5.0f - (float)h));
    const float cd = exp2f(64.f * lg2);
    f32x4 Sacc[8];
#pragma unroll
    for (int i = 0; i < 8; ++i) Sacc[i] = (f32x4){0.f, 0.f, 0.f, 0.f};
    for (int i = tid; i < 64 * 264 / 2; i += 512) ((LAS unsigned*)ST)[i] = 0u;
    u32x4 rq1[2], rq2[2], rk1[2], rk2[2], rv; f32x4 rc[2][2], rs[2][2];
    const int vt = tid >> 3, vc8 = tid & 7;
#define RET_LOAD(n) do { _Pragma("unroll") for (int e = 0; e < 2; ++e) { const int u = tid + e * 512, t = u >> 4, c8 = u & 15; \
        const bf16_t* bp = proj + (size_t)(b * 2048 + (n) * 64 + t) * 6144 + h * 256 + c8 * 8; \
        rq1[e] = *(const u32x4*)bp; rq2[e] = *(const u32x4*)(bp + 128); rk1[e] = *(const u32x4*)(bp + 1024); rk2[e] = *(const u32x4*)(bp + 1024 + 128); \
        const float* cp = ropec + (size_t)((n) * 64 + t) * 128 + c8 * 8; const float* sp = ropes + (size_t)((n) * 64 + t) * 128 + c8 * 8; \
        rc[e][0] = *(const f32x4*)cp; rc[e][1] = *(const f32x4*)(cp + 4); rs[e][0] = *(const f32x4*)sp; rs[e][1] = *(const f32x4*)(sp + 4); } \
        rv = *(const u32x4*)(proj + (size_t)(b * 2048 + (n) * 64 + vt) * 6144 + 2048 + h * 512 + sl * 64 + vc8 * 8); } while (0)
    RET_LOAD(0);
    for (int n_ = 0; n_ < 32; ++n_) {
        int n = __builtin_amdgcn_readfirstlane(n_); asm volatile("" : "+s"(n));
#pragma unroll
        for (int e = 0; e < 2; ++e) {
            const int u = tid + e * 512, t = u >> 4, c8 = u & 15;
            float q1[8], q2[8], k1[8], k2[8], a[8], c[8];
            unpack8(rq1[e], q1); unpack8(rq2[e], q2); unpack8(rk1[e], k1); unpack8(rk2[e], k2);
            const float kd = exp2f((float)(63 - t) * lg2);
#pragma unroll
            for (int j = 0; j < 8; ++j) { const float co = rc[e][j >> 2][j & 3], si = rs[e][j >> 2][j & 3]; a[j] = q1[j] * co - q2[j] * si; c[j] = q1[j] * si + q2[j] * co; }
            *(LAS u32x4*)(Qs + t * 264 + c8 * 8) = pack8(a); *(LAS u32x4*)(Qs + t * 264 + 128 + c8 * 8) = pack8(c);
#pragma unroll
            for (int j = 0; j < 8; ++j) { const float co = rc[e][j >> 2][j & 3], si = rs[e][j >> 2][j & 3]; a[j] = (k1[j] * co - k2[j] * si) * 0.0625f; c[j] = (k1[j] * si + k2[j] * co) * 0.0625f; }
            *(LAS u32x4*)(Ks + t * 264 + c8 * 8) = pack8(a); *(LAS u32x4*)(Ks + t * 264 + 128 + c8 * 8) = pack8(c);
#pragma unroll
            for (int j = 0; j < 8; ++j) { KdT[tsw(c8 * 8 + j, t)] = f2bf(a[j] * kd); KdT[tsw(128 + c8 * 8 + j, t)] = f2bf(c[j] * kd); }
        }
        { const unsigned vw[4] = {rv.x, rv.y, rv.z, rv.w};
#pragma unroll
          for (int j = 0; j < 4; ++j) { VT[tsw(vc8 * 8 + 2 * j, vt)] = (bf16_t)(vw[j] & 0xffffu); VT[tsw(vc8 * 8 + 2 * j + 1, vt)] = (bf16_t)(vw[j] >> 16); } }
        lds_sync();
        if (n + 1 < 32) RET_LOAD(n + 1);
        bf16x8 qf[8];
#pragma unroll
        for (int k = 0; k < 8; ++k) qf[k] = ldf(Qs, 264, (w & 3) * 16, k, lane);
        { const int ib = w & 3, i = ib * 16 + l16;
#pragma unroll
          for (int jj = 0; jj < 2; ++jj) { const int jb = (w >> 2) * 2 + jj; f32x4 acc = (f32x4){0.f, 0.f, 0.f, 0.f};
              if (jb <= ib) {
#pragma unroll
                  for (int k = 0; k < 8; ++k) MF(acc, ldf(Ks, 264, jb * 16, k, lane), qf[k]); }
              const int j0 = jb * 16 + 4 * q4; float pv[4];
#pragma unroll
              for (int r = 0; r < 4; ++r) { const int j = j0 + r; pv[r] = (i >= j) ? acc[r] * exp2f((float)(i - j) * lg2) : 0.f; }
              u32x2 pkd; pkd.x = pk2(pv[0], pv[1]); pkd.y = pk2(pv[2], pv[3]); *(LAS u32x2*)(Ps + i * 72 + j0) = pkd; } }
        lds_sync();
        { const int ib = w & 3, i = ib * 16 + l16; const float qd = exp2f((float)(i + 1) * lg2); float ss = 0.f;
          const size_t row = (size_t)b * 2048 + n * 64 + i;
#pragma unroll
          for (int dd = 0; dd < 2; ++dd) { const int dvb = (w >> 2) * 2 + dd; f32x4 acc = (f32x4){0.f, 0.f, 0.f, 0.f};
#pragma unroll
              for (int k = 0; k < 8; ++k) MF(acc, ldf(ST, 264, dvb * 16, k, lane), qf[k]);
              acc = acc * qd;
#pragma unroll
              for (int k = 0; k < 2; ++k) MF(acc, ldfs(VT, dvb * 16, k, lane), ldf(Ps, 72, ib * 16, k, lane));
              ss += acc[0] * acc[0] + acc[1] * acc[1] + acc[2] * acc[2] + acc[3] * acc[3];
              u32x2 pkd; pkd.x = pk2(acc[0], acc[1]); pkd.y = pk2(acc[2], acc[3]);
              *(u32x2*)(oraw + row * 2048 + h * 512 + sl * 64 + dvb * 16 + 4 * q4) = pkd; }
          ss += __shfl_xor(ss, 16); ss += __shfl_xor(ss, 32);
          if (q4 == 0) ssq[row * 64 + h * 16 + sl * 2 + (w >> 2)] = ss; }
        { bf16x8 kf[2][2];
#pragma unroll
          for (int a = 0; a < 2; ++a)
#pragma unroll
              for (int k = 0; k < 2; ++k) kf[a][k] = ldfs(KdT, w * 32 + a * 16, k, lane);
#pragma unroll
          for (int d = 0; d < 4; ++d) { const bf16x8 v0 = ldfs(VT, d * 16, 0, lane), v1 = ldfs(VT, d * 16, 1, lane);
#pragma unroll
              for (int a = 0; a < 2; ++a) { Sacc[a * 4 + d] = Sacc[a * 4 + d] * cd; MF(Sacc[a * 4 + d], kf[a][0], v0); MF(Sacc[a * 4 + d], kf[a][1], v1); } } }
        lds_sync();
#pragma unroll
        for (int a = 0; a < 2; ++a)
#pragma unroll
            for (int d = 0; d < 4; ++d) { const f32x4 s = Sacc[a * 4 + d]; u32x2 pkd; pkd.x = pk2(s[0], s[1]); pkd.y = pk2(s[2], s[3]);
                *(LAS u32x2*)(ST + (d * 16 + l16) * 264 + w * 32 + a * 16 + 4 * q4) = pkd; }
    }
#undef RET_LOAD
    float* so = P.out + O_RETP + (size_t)(b * 4 + h) * 256 * 512 + sl * 64 + (size_t)(w * 32 + 4 * q4) * 512 + l16;
    asm volatile("" : "+v"(so));
#pragma unroll
    for (int a = 0; a < 2; ++a)
#pragma unroll
        for (int d = 0; d < 4; ++d)
#pragma unroll
            for (int r = 0; r < 4; ++r) so[(size_t)(a * 16 + r) * 512 + d * 16] = Sacc[a * 4 + d][r];
    lds_sync();
}

__device__ __forceinline__ void ret_sample_task(const Params& P, int task, lds_t lds, int tid) {
    asm volatile("" : "+v"(tid));
    const int b = task >> 4, h = (task >> 2) & 3, sl = task & 3;
    const bf16_t* proj = (const bf16_t*)(P.ws + WS_PROJ);
    const float* ropec = (const float*)(P.ws + WS_ROPE); const float* ropes = ropec + 2052 * 128;
    bf16_t* oraw = (bf16_t*)(P.ws + WS_ORAW); float* ssq = (float*)(P.ws + WS_SSQ);
    lf_t qs = (lf_t)lds, ks = qs + 1024, vs = ks + 1024, red = vs + 512, Am = red + 512, ssr = Am + 16, redp = ssr + 16;
    const float lg2 = log2f(1.0f - exp2f(-5.0f - (float)h));
    const size_t row0 = (size_t)MP + b * 4;
#pragma unroll
    for (int e = 0; e < 2; ++e) {
        const int u = tid + e * 512, mat = u >> 9, t = (u >> 7) & 3, j = u & 127;
        const bf16_t* bp = proj + (row0 + t) * 6144 + mat * 1024 + h * 256 + j;
        const float x1 = bf2f(bp[0]), x2 = bf2f(bp[128]);
        const float co = ropec[(2048 + t) * 128 + j], si = ropes[(2048 + t) * 128 + j];
        const float sc = mat ? 0.0625f : 1.f; lf_t dst = mat ? ks : qs;
        dst[t * 256 + j] = (x1 * co - x2 * si) * sc; dst[t * 256 + 128 + j] = (x1 * si + x2 * co) * sc;
    }
    { const int t = tid >> 7, c = tid & 127; vs[t * 128 + c] = bf2f(proj[(row0 + t) * 6144 + 2048 + h * 512 + sl * 128 + c]); }
    lds_sync();
    { const int p = tid >> 5, l32 = tid & 31, i = p >> 2, j = p & 3; float s = 0.f;
      for (int d = l32; d < 256; d += 32) s += qs[i * 256 + d] * ks[j * 256 + d];
#pragma unroll
      for (int o = 16; o >= 1; o >>= 1) s += __shfl_xor(s, o);
      if (l32 == 0) Am[p] = (i >= j) ? s * exp2f((float)(i - j) * lg2) : 0.f; }
    lds_sync();
    { const int c4 = tid & 31, dg = tid >> 5;
      const size_t sbase = ((size_t)(b * 4 + h) * 256) * 512 + sl * 128 + c4 * 4;
      const float* Sin = P.in[2] + sbase; float* Sout = P.out + O_RETS + sbase;
      f32x4 vp[4], pq[4];
#pragma unroll
      for (int j = 0; j < 4; ++j) { vp[j] = *(LAS f32x4*)(vs + j * 128 + c4 * 4) * exp2f((float)(3 - j) * lg2); pq[j] = (f32x4){0.f, 0.f, 0.f, 0.f}; }
      const float g4 = exp2f(4.f * lg2);
      f32x4 sv[16];
#pragma unroll
      for (int dd = 0; dd < 16; ++dd) sv[dd] = __builtin_nontemporal_load((const f32x4*)(Sin + (size_t)(dg * 16 + dd) * 512));
#pragma unroll
      for (int dd = 0; dd < 16; ++dd) { const int dk = dg * 16 + dd; const f32x4 s = sv[dd];
          f32x4 sn = s * g4;
#pragma unroll
          for (int i = 0; i < 4; ++i) { pq[i] += s * qs[i * 256 + dk]; sn += vp[i] * ks[i * 256 + dk]; }
          __builtin_nontemporal_store(sn, (f32x4*)(Sout + (size_t)dk * 512)); }
#pragma unroll
      for (int i = 0; i < 4; ++i) *(LAS f32x4*)(redp + (dg * 4 + i) * 128 + c4 * 4) = pq[i]; }
    lds_sync();
    { float s = 0.f;
#pragma unroll
      for (int g = 0; g < 16; ++g) s += redp[g * 512 + tid];
      red[tid] = s; }
    lds_sync();
    if (tid < 128) {
        const int dv = tid; float v[4];
#pragma unroll
        for (int j = 0; j < 4; ++j) v[j] = vs[j * 128 + dv];
#pragma unroll
        for (int i = 0; i < 4; ++i) { float o = exp2f((float)(i + 1) * lg2) * red[i * 128 + dv];
#pragma unroll
            for (int j = 0; j < 4; ++j) o += Am[i * 4 + j] * v[j];
            oraw[(row0 + i) * 2048 + h * 512 + sl * 128 + dv] = f2bf(o);
            float s2 = o * o;
#pragma unroll
            for (int of = 32; of >= 1; of >>= 1) s2 += __shfl_xor(s2, of);
            if ((tid & 63) == 0) ssr[(tid >> 6) * 4 + i] = s2; }
    }
    lds_sync();
    if (tid < 16) { const int i = tid >> 2, k = tid & 3; const int slot = (k == 0) ? sl : 4 + 3 * sl + (k - 1); ssq[(row0 + i) * 64 + h * 16 + slot] = (k == 0) ? ssr[i] + ssr[4 + i] : 0.f; }
    lds_sync();
}

__device__ __forceinline__ void phase_retention(const Params& P, lds_t lds, int bid, int nb, int tid) {
#ifndef SUBREP
#define SUBREP 0
#endif
    if (bid & 1) for (int t = bid; t < 2048; t += nb) ret_sample_task(P, t, lds, tid);
    for (int t = bid; t < 256; t += nb) ret_prompt_task(P, t, lds, tid);
    if (!(bid & 1)) for (int t = bid; t < 2048; t += nb) ret_sample_task(P, t, lds, tid);
}
#define XB_TMO      128
#define XB_XCNT(j)  (256  + 64 * (j))
#define XB_XSUB(j)  (1280 + 64 * (j))
#define XB_XGEN(j)  (2304 + 64 * (j))
#define XB_TOP      3328
#define XB_TOPGEN   3392
#define XCD_BAR_WORDS 3456
#define XB_SPIN_CAP (1u << 18)

__device__ __forceinline__ unsigned xb_ld(unsigned* p)              { return __hip_atomic_load(p, __ATOMIC_RELAXED, __HIP_MEMORY_SCOPE_AGENT); }
__device__ __forceinline__ unsigned xb_add(unsigned* p, unsigned v) { return __hip_atomic_fetch_add(p, v, __ATOMIC_RELAXED, __HIP_MEMORY_SCOPE_AGENT); }
__device__ __forceinline__ unsigned xb_xcc_id() { return (unsigned)__builtin_amdgcn_s_getreg((3 << 11) | 20) & 0xFu; }
#define XB_SPIN(cond, bar) do { unsigned _sp = 0; while (cond) { __builtin_amdgcn_s_sleep(1); \
    if ((++_sp & 255u) == 0u) { if (xb_ld(&(bar)[XB_TMO])) break; if (_sp > XB_SPIN_CAP) { atomicAdd(&(bar)[XB_TMO], 1u); break; } } } } while (0)

struct XcdBarrier {
    unsigned* bar; unsigned x;
    volatile LAS unsigned* st;
};

__device__ __forceinline__ XcdBarrier xcd_barrier_post(unsigned* bar, volatile LAS unsigned* st) {
    XcdBarrier b; b.bar = bar; b.x = xb_xcc_id(); b.st = st;
    if (threadIdx.x == 0) (void)xb_add(&bar[XB_XCNT(b.x)], 1u);
    return b;
}
__device__ __forceinline__ void xcd_barrier_complete(unsigned* bar, unsigned x, unsigned& nloc, unsigned& nx) {
    const unsigned G = gridDim.x * gridDim.y * gridDim.z;
    unsigned sum, cnt, mine, sp = 0u;
    for (;;) {
        sum = 0u; cnt = 0u; mine = 0u;
#pragma unroll
        for (unsigned j = 0; j < 16; ++j) { const unsigned c = xb_ld(&bar[XB_XCNT(j)]); sum += c; cnt += (c > 0u) ? 1u : 0u; mine = (j == x) ? c : mine; }
        if (sum == G) break;
        __builtin_amdgcn_s_sleep(1);
        if ((++sp & 255u) == 0u) { if (xb_ld(&bar[XB_TMO])) break; if (sp > XB_SPIN_CAP) { atomicAdd(&bar[XB_TMO], 1u); break; } }
    }
    nloc = mine > 0u ? mine : 1u; nx = cnt > 0u ? cnt : 1u;
}

__device__ __forceinline__ void xcd_barrier(const XcdBarrier& b) {
    asm volatile("s_waitcnt vmcnt(0)" ::: "memory");
    __syncthreads();
    if (threadIdx.x == 0) {
        unsigned* bar = b.bar;
        __builtin_amdgcn_s_waitcnt(0);
        unsigned nloc = b.st[0], nx = b.st[1];
        if (nloc == 0u) { xcd_barrier_complete(bar, b.x, nloc, nx); b.st[0] = nloc; b.st[1] = nx; }
        const unsigned old = xb_add(&bar[XB_XSUB(b.x)], 1u);
        const unsigned gen = old / nloc;
        if (old + 1u == (gen + 1u) * nloc) {
            __builtin_amdgcn_fence(__ATOMIC_RELEASE, "agent");
            asm volatile("s_waitcnt vmcnt(0)" ::: "memory");
            const unsigned og = xb_add(&bar[XB_TOP], 1u);
            const unsigned tg = og / nx;
            if (og + 1u == (tg + 1u) * nx) xb_add(&bar[XB_TOPGEN], 1u);
            else XB_SPIN(xb_ld(&bar[XB_TOPGEN]) == tg, bar);
            __builtin_amdgcn_fence(__ATOMIC_ACQUIRE, "agent");
            xb_add(&bar[XB_XGEN(b.x)], 1u);
            asm volatile("s_waitcnt vmcnt(0)" ::: "memory");
        } else {
            XB_SPIN(xb_ld(&bar[XB_XGEN(b.x)]) == gen, bar);
            __builtin_amdgcn_fence(__ATOMIC_ACQUIRE, "agent");
            asm volatile("s_waitcnt vmcnt(0)" ::: "memory");
        }
    }
    __syncthreads();
}


__device__ __forceinline__ float softplus_f(float x) { return x > 20.f ? x : log1pf(__expf(x)); }
__device__ __forceinline__ unsigned char* grec(const Params& P, int b, int hv, int n) { return P.ws + WS_R2 + (size_t)((b * 16 + hv) * 32 + n) * GREC; }
constexpr int R_W = 0, R_U = 16384, R_ATT = 32768, R_QG = 40960, R_KG = 57344, R_EGL = 73728;

struct GaPre { u32x4 xq[7], xv[7]; float a, bb; };
__device__ __forceinline__ void gdn_prep_load(const Params& P, int task, int tid, GaPre& R) {
    const int b = task >> 8, hk = (task >> 5) & 7, n = task & 31;
    const int lane = tid & 63, w = tid >> 6, mat = tid >> 8, rsg = (tid >> 4) & 15, cgp = tid & 15;
    const bf16_t* proj = (const bf16_t*)(P.ws + WS_PROJ); const float* ba = (const float*)(P.ws + WS_BA);
    const int colq = mat * 1024 + hk * 128 + cgp * 8, colv = 2048 + (hk * 2 + mat) * 128 + cgp * 8;
#pragma unroll
    for (int rr = 0; rr < 7; ++rr) { const int t = n * 64 + rsg * 4 - 3 + rr; const bf16_t* rp = proj + ((size_t)b * 2048 + (t >= 0 ? t : 0)) * 6144;
        R.xq[rr] = *(const u32x4*)(rp + colq); R.xv[rr] = *(const u32x4*)(rp + colv);
        if (t < 0) { R.xq[rr] = (u32x4){0u, 0u, 0u, 0u}; R.xv[rr] = (u32x4){0u, 0u, 0u, 0u}; } }
    R.a = 0.f; R.bb = 0.f;
    if (w < 2) { const size_t row = (size_t)b * 2048 + n * 64 + lane; R.a = ba[row * 32 + 16 + hk * 2 + w]; R.bb = ba[row * 32 + hk * 2 + w]; }
}
__device__ __forceinline__ void gdn_prep_task(const Params& P, int task, int next_task, lds_t lds, int tid, GaPre& R) {
    asm volatile("" : "+v"(tid));
    const int b_ = task >> 8, hk = (task >> 5) & 7, n = task & 31;
    const int lane = tid & 63, w = tid >> 6, q4 = lane >> 4, l16 = lane & 15;
    const bf16_t* proj = (const bf16_t*)(P.ws + WS_PROJ); const float* ba = (const float*)(P.ws + WS_BA);
    const float* wconv = P.in[18];
    lbf_t Qn = (lbf_t)lds, Kn = Qn + 64 * 136, KbgT = Kn + 64 * 136  , VbT = KbgT + 2 * 128 * 72  ;
    lf_t Lm = (lf_t)(lds + 108544)  , Gs = (lf_t)(lds + 108544 + 2 * 16384)  , Bs = Gs + 128;
    const size_t r0 = (size_t)b_ * 2048 + n * 64;
    if (w < 2) {
        const int hvg = hk * 2 + w;
        const float a = R.a, bb = R.bb;
        float g = -__expf(P.in[19][hvg]) * softplus_f(a + P.in[20][hvg]);
#pragma unroll
        for (int o = 1; o < 64; o <<= 1) { const float t = __shfl_up(g, o); if (lane >= o) g += t; }
        Gs[w * 64 + lane] = g; Bs[w * 64 + lane] = sigmoid_f(bb);
    }
    lds_sync();
    { int b = __builtin_amdgcn_readfirstlane(b_); asm volatile("" : "+s"(b)); const int mat = tid >> 8, rsg = (tid >> 4) & 15, cgp = tid & 15;
      {
        const int col = mat * 1024 + hk * 128 + cgp * 8; float x[7][8], wv[4][8];
#pragma unroll
        for (int i = 0; i < 4; ++i) { const f32x4 a0 = *(const f32x4*)(wconv + i * 4096 + col), a1 = *(const f32x4*)(wconv + i * 4096 + col + 4);
            wv[i][0] = a0[0]; wv[i][1] = a0[1]; wv[i][2] = a0[2]; wv[i][3] = a0[3]; wv[i][4] = a1[0]; wv[i][5] = a1[1]; wv[i][6] = a1[2]; wv[i][7] = a1[3]; }
#pragma unroll
        for (int rr = 0; rr < 7; ++rr) unpack8(R.xq[rr], x[rr]);
#pragma unroll
        for (int rr = 0; rr < 4; ++rr) {
            float o[8], ss = 0.f;
#pragma unroll
            for (int j = 0; j < 8; ++j) { const float cv = wv[0][j] * x[rr][j] + wv[1][j] * x[rr + 1][j] + wv[2][j] * x[rr + 2][j] + wv[3][j] * x[rr + 3][j]; o[j] = silu_f(cv); ss += o[j] * o[j]; }
            ss += __shfl_xor(ss, 1); ss += __shfl_xor(ss, 2); ss += __shfl_xor(ss, 4); ss += __shfl_xor(ss, 8);
            const float rn = rsqrtf(ss + EPS) * (mat == 0 ? 0.08838834764831845f : 1.f);
#pragma unroll
            for (int j = 0; j < 8; ++j) o[j] *= rn;
            const int r = rsg * 4 + rr;
            *(LAS u32x4*)((mat == 0 ? Qn : Kn) + r * 136 + cgp * 8) = pack8(o);
#pragma unroll
            for (int hv = 0; hv < 2; ++hv) {
                const float G = Gs[hv * 64 + r], Gl = Gs[hv * 64 + 63], be = Bs[hv * 64 + r];
                unsigned char* rec = grec(P, b, hk * 2 + hv, n); float y[8];
                if (mat == 0) { const float e = __expf(G);
#pragma unroll
                    for (int j = 0; j < 8; ++j) y[j] = o[j] * e;
                    *(u32x4*)(rec + R_QG + (r * 128 + cgp * 8) * 2) = pack8(y);
                } else { const float e = __expf(Gl - G), e2 = be * __expf(G);
#pragma unroll
                    for (int j = 0; j < 8; ++j) y[j] = o[j] * e;
                    *(u32x4*)(rec + R_KG + (r * 128 + cgp * 8) * 2) = pack8(y);
#pragma unroll
                    for (int j = 0; j < 8; ++j) KbgT[hv * 128 * 72 + tsw(cgp * 8 + j, r)] = f2bf(o[j] * e2);
                }
            }
        }
      }
      asm volatile("" ::: "memory"); __builtin_amdgcn_sched_barrier(0);
      {
        const int hv = mat, col = 2048 + (hk * 2 + hv) * 128 + cgp * 8; float x[7][8], wv[4][8];
#pragma unroll
        for (int i = 0; i < 4; ++i) { const f32x4 a0 = *(const f32x4*)(wconv + i * 4096 + col), a1 = *(const f32x4*)(wconv + i * 4096 + col + 4);
            wv[i][0] = a0[0]; wv[i][1] = a0[1]; wv[i][2] = a0[2]; wv[i][3] = a0[3]; wv[i][4] = a1[0]; wv[i][5] = a1[1]; wv[i][6] = a1[2]; wv[i][7] = a1[3]; }
#pragma unroll
        for (int rr = 0; rr < 7; ++rr) unpack8(R.xv[rr], x[rr]);
#pragma unroll
        for (int rr = 0; rr < 4; ++rr) { const int r = rsg * 4 + rr; const float be = Bs[hv * 64 + r];
#pragma unroll
            for (int j = 0; j < 8; ++j) { const float cv = wv[0][j] * x[rr][j] + wv[1][j] * x[rr + 1][j] + wv[2][j] * x[rr + 2][j] + wv[3][j] * x[rr + 3][j];
                VbT[hv * 128 * 72 + tsw(cgp * 8 + j, r)] = f2bf(silu_f(cv) * be); } }
      }
      if (tid < 2) *(float*)(grec(P, b, hk * 2 + tid, n) + R_EGL) = __expf(Gs[tid * 64 + 63]);
    }
    lds_sync();
    int b = __builtin_amdgcn_readfirstlane(b_); asm volatile("" : "+s"(b));
    if (w < 4) {
        const int ib = w;
        for (int jb = 0; jb <= ib; ++jb) { f32x4 acc = (f32x4){0.f, 0.f, 0.f, 0.f};
            mma16<4>(acc, Kn + ib * 16 * 136, 136, Kn + jb * 16 * 136, 136, lane);
#pragma unroll
            for (int hv = 0; hv < 2; ++hv) { const int j = jb * 16 + l16; const float Gj = Gs[hv * 64 + j];
#pragma unroll
                for (int r = 0; r < 4; ++r) { const int i = ib * 16 + 4 * q4 + r; Lm[hv * 4096 + i * 64 + j] = (i > j) ? acc[r] * Bs[hv * 64 + i] * __expf(Gs[hv * 64 + i] - Gj) : 0.f; } } }
    } else {
        const int ib = w - 4, i = ib * 16 + l16;
        for (int jb = 0; jb < 4; ++jb) { f32x4 acc = (f32x4){0.f, 0.f, 0.f, 0.f};
            if (jb <= ib) mma16<4>(acc, Kn + jb * 16 * 136, 136, Qn + ib * 16 * 136, 136, lane);
#pragma unroll
            for (int hv = 0; hv < 2; ++hv) { const float Gi = Gs[hv * 64 + i]; float y[4];
#pragma unroll
                for (int r = 0; r < 4; ++r) { const int j = jb * 16 + 4 * q4 + r; y[r] = (i >= j) ? acc[r] * __expf(Gi - Gs[hv * 64 + j]) : 0.f; }
                u32x2 pkd; pkd.x = pk2(y[0], y[1]); pkd.y = pk2(y[2], y[3]);
                *(u32x2*)(grec(P, b, hk * 2 + hv, n) + R_ATT + (i * 64 + jb * 16 + 4 * q4) * 2) = pkd; } }
    }
    lds_sync();
    if (next_task < 2048) gdn_prep_load(P, next_task, tid, R);
    if (w < 2) {
        lf_t L = Lm + w * 4096; lbf_t T = (lbf_t)(lds + 142336) + w * 64 * 72;
        lbf_t stg = (w == 0 ? Qn : Kn);
        lbf_t L21b = stg, T11T = stg + 32 * 40, T22n = stg + 2 * 32 * 40, RT = stg + 3 * 32 * 40;
        const int half = lane >> 5, c = lane & 31;
        lf_t Lh = L + half * (32 * 64 + 32);
        float t[32];
#pragma unroll
        for (int i = 0; i < 32; ++i) {
            float s0 = (i == c) ? 1.f : 0.f, s1 = 0.f;
#pragma unroll
            for (int j4 = 0; j4 < (i + 3) / 4; ++j4) { const f32x4 l = *(LAS f32x4*)(Lh + i * 64 + j4 * 4);
#pragma unroll
                for (int e = 0; e < 4; ++e) { const int j = j4 * 4 + e; if (j < i) { if (e & 1) s1 -= l[e] * t[j]; else s0 -= l[e] * t[j]; } } }
            t[i] = s0 + s1;
        }
        { const int i = lane >> 1, c0 = (lane & 1) * 16; float f[16];
#pragma unroll
          for (int v = 0; v < 4; ++v) { const f32x4 l = *(LAS f32x4*)(L + (32 + i) * 64 + c0 + v * 4); f[v * 4] = l[0]; f[v * 4 + 1] = l[1]; f[v * 4 + 2] = l[2]; f[v * 4 + 3] = l[3]; }
          *(LAS u32x4*)(L21b + i * 40 + c0) = pack8(f); *(LAS u32x4*)(L21b + i * 40 + c0 + 8) = pack8(f + 8);
          *(LAS u32x4*)(T + i * 72 + 32 + c0) = (u32x4){0u, 0u, 0u, 0u}; *(LAS u32x4*)(T + i * 72 + 32 + c0 + 8) = (u32x4){0u, 0u, 0u, 0u}; }
        if (half == 0) {
#pragma unroll
            for (int v = 0; v < 4; ++v) *(LAS u32x4*)(T11T + c * 40 + v * 8) = pack8(t + v * 8);
        }
#pragma unroll
        for (int i = 0; i < 32; ++i) { const bf16_t tb = f2bf(t[i]); T[(half * 32 + i) * 72 + half * 32 + c] = tb; if (half) T22n[i * 40 + c] = tb; }
#pragma unroll
        for (int ib = 0; ib < 2; ++ib)
#pragma unroll
            for (int cb = 0; cb < 2; ++cb) { f32x4 acc = (f32x4){0.f, 0.f, 0.f, 0.f};
                MF(acc, ldf(L21b, 40, ib * 16, 0, lane), ldf(T11T, 40, cb * 16, 0, lane));
                u32x2 pkd; pkd.x = pk2(acc[0], acc[1]); pkd.y = pk2(acc[2], acc[3]);
                *(LAS u32x2*)(RT + (cb * 16 + l16) * 40 + ib * 16 + 4 * q4) = pkd; }
#pragma unroll
        for (int ib = 0; ib < 2; ++ib)
#pragma unroll
            for (int cb = 0; cb < 2; ++cb) { f32x4 acc = (f32x4){0.f, 0.f, 0.f, 0.f};
                MF(acc, ldf(T22n, 40, ib * 16, 0, lane), ldf(RT, 40, cb * 16, 0, lane));
#pragma unroll
                for (int r = 0; r < 4; ++r) T[(32 + ib * 16 + 4 * q4 + r) * 72 + cb * 16 + l16] = f2bf(-acc[r]); }
    }
    lds_sync();
    { int b = __builtin_amdgcn_readfirstlane(b_); asm volatile("" : "+s"(b)); const int hv = w >> 2, kind = (w >> 1) & 1, half = w & 1;
      lbf_t X = (kind ? VbT : KbgT) + hv * 128 * 72; lbf_t T = (lbf_t)(lds + 142336) + hv * 64 * 72;
      unsigned char* rec = grec(P, b, hk * 2 + hv, n) + (kind ? R_U : R_W);
      bf16x8 tf[4][2];
#pragma unroll
      for (int ib = 0; ib < 4; ++ib) { tf[ib][0] = ldf(T, 72, ib * 16, 0, lane); tf[ib][1] = ldf(T, 72, ib * 16, 1, lane); }
#pragma unroll
      for (int db = 0; db < 4; ++db) { const bf16x8 x0 = ldfs(X, (half * 4 + db) * 16, 0, lane), x1 = ldfs(X, (half * 4 + db) * 16, 1, lane);
#pragma unroll
          for (int ib = 0; ib < 4; ++ib) { const int dkb = half * 4 + db; f32x4 acc = (f32x4){0.f, 0.f, 0.f, 0.f};
              MF(acc, x0, tf[ib][0]); MF(acc, x1, tf[ib][1]);
              u32x2 pkd; pkd.x = pk2(acc[0], acc[1]); pkd.y = pk2(acc[2], acc[3]);
              *(u32x2*)(rec + ((ib * 16 + l16) * 128 + dkb * 16 + 4 * q4) * 2) = pkd; } } }
    lds_sync();
}

__device__ __forceinline__ void gdn_scan_task(const Params& P, int task, lds_t lds, int tid) {
    asm volatile("" : "+v"(tid));
    const int b = task >> 4, hvg = task & 15;
    const int lane = tid & 63, w = tid >> 6, q4 = lane >> 4, l16 = lane & 15;
    const bf16_t* proj = (const bf16_t*)(P.ws + WS_PROJ); bf16_t* og = (bf16_t*)(P.ws + WS_OG);
    lbf_t Wl = (lbf_t)lds, Ul = Wl + 64 * 136, QGl = Ul + 64 * 136, ATl = QGl + 64 * 136, KgT = ATl + 64 * 72, ST = KgT + 128 * 72, VnT = ST + 128 * 136;
    lf_t Os = (lf_t)lds;
    f32x4 Sacc[8];
#pragma unroll
    for (int i = 0; i < 8; ++i) Sacc[i] = (f32x4){0.f, 0.f, 0.f, 0.f};
    for (int i = tid; i < 128 * 136 / 2; i += 512) ((LAS unsigned*)ST)[i] = 0u;
    u32x4 rw[2], ru[2], rq[2], rk[2], ra, rz[2]; float regl;
    const int nrow = tid >> 3, ncs = (tid & 7) * 16;
    const float* normw = P.in[21];
#define GB_LOAD(n) do { const unsigned char* rec = grec(P, b, hvg, (n)); \
        _Pragma("unroll") for (int e = 0; e < 2; ++e) { const int off = (tid + e * 512) * 16; rw[e] = *(const u32x4*)(rec + R_W + off); ru[e] = *(const u32x4*)(rec + R_U + off); \
            rq[e] = *(const u32x4*)(rec + R_QG + off); rk[e] = *(const u32x4*)(rec + R_KG + off); } \
        ra = *(const u32x4*)(rec + R_ATT + tid * 16); regl = *(const float*)(rec + R_EGL); \
        const bf16_t* zp = proj + ((size_t)b * 2048 + (n) * 64 + nrow) * 6144 + 4096 + hvg * 128 + ncs; rz[0] = *(const u32x4*)zp; rz[1] = *(const u32x4*)(zp + 8); } while (0)
    GB_LOAD(0);
    for (int n_ = 0; n_ < 32; ++n_) {
        int n = __builtin_amdgcn_readfirstlane(n_); asm volatile("" : "+s"(n));
        const float egl = regl; const u32x4 z0 = rz[0], z1 = rz[1];
#pragma unroll
        for (int e = 0; e < 2; ++e) { const int cidx = tid + e * 512, r = cidx >> 4, c8 = cidx & 15;
            *(LAS u32x4*)(Wl + r * 136 + c8 * 8) = rw[e]; *(LAS u32x4*)(Ul + r * 136 + c8 * 8) = ru[e]; *(LAS u32x4*)(QGl + r * 136 + c8 * 8) = rq[e];
            const unsigned kw[4] = {rk[e].x, rk[e].y, rk[e].z, rk[e].w};
#pragma unroll
            for (int j = 0; j < 4; ++j) { KgT[tsw(c8 * 8 + 2 * j, r)] = (bf16_t)(kw[j] & 0xffffu); KgT[tsw(c8 * 8 + 2 * j + 1, r)] = (bf16_t)(kw[j] >> 16); } }
        *(LAS u32x4*)(ATl + (tid >> 3) * 72 + (tid & 7) * 8) = ra;
        lds_sync();
        if (n + 1 < 32) GB_LOAD(n + 1);
        const int ib = w & 3;
        bf16x8 wf[4];
#pragma unroll
        for (int k = 0; k < 4; ++k) wf[k] = ldf(Wl, 136, ib * 16, k, lane);
#pragma unroll
        for (int dd = 0; dd < 4; ++dd) { const int dvb = (w >> 2) * 4 + dd; f32x4 acc = (f32x4){0.f, 0.f, 0.f, 0.f};
#pragma unroll
            for (int k = 0; k < 4; ++k) MF(acc, wf[k], ldf(ST, 136, dvb * 16, k, lane));
            float vn[4];
#pragma unroll
            for (int r = 0; r < 4; ++r) vn[r] = bf2f(Ul[(ib * 16 + 4 * q4 + r) * 136 + dvb * 16 + l16]) - acc[r];
            u32x2 pkd; pkd.x = pk2(vn[0], vn[1]); pkd.y = pk2(vn[2], vn[3]);
            *(LAS u32x2*)(VnT + (dvb * 16 + l16) * 72 + ib * 16 + 4 * q4) = pkd; }
        lds_sync();
        f32x4 oacc[4];
        { bf16x8 qf[4], af[2];
#pragma unroll
          for (int k = 0; k < 4; ++k) qf[k] = ldf(QGl, 136, ib * 16, k, lane);
#pragma unroll
          for (int k = 0; k < 2; ++k) af[k] = ldf(ATl, 72, ib * 16, k, lane);
#pragma unroll
          for (int dd = 0; dd < 4; ++dd) { const int dvb = (w >> 2) * 4 + dd; oacc[dd] = (f32x4){0.f, 0.f, 0.f, 0.f};
#pragma unroll
              for (int k = 0; k < 4; ++k) MF(oacc[dd], qf[k], ldf(ST, 136, dvb * 16, k, lane));
#pragma unroll
              for (int k = 0; k < 2; ++k) MF(oacc[dd], af[k], ldf(VnT, 72, dvb * 16, k, lane)); } }
        { const bf16x8 k0f = ldfs(KgT, w * 16, 0, lane), k1f = ldfs(KgT, w * 16, 1, lane);
#pragma unroll
          for (int d = 0; d < 8; ++d) { Sacc[d] = Sacc[d] * egl; MF(Sacc[d], k0f, ldf(VnT, 72, d * 16, 0, lane)); MF(Sacc[d], k1f, ldf(VnT, 72, d * 16, 1, lane)); } }
#pragma unroll
        for (int dd = 0; dd < 4; ++dd) { const int dvb = (w >> 2) * 4 + dd;
#pragma unroll
            for (int r = 0; r < 4; ++r) Os[(ib * 16 + 4 * q4 + r) * 132 + dvb * 16 + l16] = oacc[dd][r]; }
        lds_sync();
#pragma unroll
        for (int d = 0; d < 8; ++d) { const f32x4 s = Sacc[d]; u32x2 pkd; pkd.x = pk2(s[0], s[1]); pkd.y = pk2(s[2], s[3]);
            *(LAS u32x2*)(ST + (d * 16 + l16) * 136 + w * 16 + 4 * q4) = pkd; }
        { float o[16], zf[16], ss = 0.f;
#pragma unroll
          for (int j4 = 0; j4 < 4; ++j4) { const f32x4 v = *(LAS f32x4*)(Os + nrow * 132 + ncs + j4 * 4); o[j4 * 4] = v[0]; o[j4 * 4 + 1] = v[1]; o[j4 * 4 + 2] = v[2]; o[j4 * 4 + 3] = v[3]; }
#pragma unroll
          for (int j = 0; j < 16; ++j) ss += o[j] * o[j];
          ss += __shfl_xor(ss, 1); ss += __shfl_xor(ss, 2); ss += __shfl_xor(ss, 4);
          const float rn = rsqrtf(ss * (1.f / 128.f) + EPS);
          unpack8(z0, zf); unpack8(z1, zf + 8);
#pragma unroll
          for (int j = 0; j < 16; ++j) o[j] = o[j] * rn * normw[ncs + j] * silu_f(zf[j]);
          bf16_t* op = og + ((size_t)b * 2048 + n * 64 + nrow) * 2048 + hvg * 128 + ncs;
          *(u32x4*)op = pack8(o); *(u32x4*)(op + 8) = pack8(o + 8); }
        lds_sync();
    }
#undef GB_LOAD
    float* so = P.out + O_GDNP + (size_t)(b * 16 + hvg) * 128 * 128 + (size_t)(w * 16 + 4 * q4) * 128 + l16;
    asm volatile("" : "+v"(so));
#pragma unroll
    for (int d = 0; d < 8; ++d)
#pragma unroll
        for (int r = 0; r < 4; ++r) so[r * 128 + d * 16] = Sacc[d][r];
    lds_sync();
}

__device__ __forceinline__ void gdn_sample_task(const Params& P, int task, lds_t lds, int tid) {
    asm volatile("" : "+v"(tid));
    const int b = task >> 4, hvg = task & 15, hk = hvg >> 1;
    const int lane = tid & 63, w = tid >> 6;
    const bf16_t* proj = (const bf16_t*)(P.ws + WS_PROJ); const float* ba = (const float*)(P.ws + WS_BA); bf16_t* og = (bf16_t*)(P.ws + WS_OG);
    const float* wconv = P.in[18];
    lf_t qs = (lf_t)lds, ks = qs + 512, vs = ks + 512, us = vs + 512, wsm = us + 512, red = wsm + 512  , vn = red + 1024, on = vn + 512,
         kkd = on + 512, qkd = kkd + 16, Gs = qkd + 16, Bs = Gs + 4, redp = Bs + 4  ;
    const size_t row0 = (size_t)MP + b * 4;
#pragma unroll
    for (int mat = 0; mat < 3; ++mat) {
        const int t = (tid >> 7) & 3, c = tid & 127;
        const int col = mat == 0 ? hk * 128 + c : (mat == 1 ? 1024 + hk * 128 + c : 2048 + hvg * 128 + c);
        float cv = 0.f;
#pragma unroll
        for (int i = 0; i < 4; ++i) { const int r = t + i;
            const float x = r < 3 ? P.in[4][(size_t)(b * 3 + r) * 4096 + col] : bf2f(proj[(row0 + r - 3) * 6144 + col]);
            cv += wconv[i * 4096 + col] * x; }
        (mat == 0 ? qs : (mat == 1 ? ks : vs))[t * 128 + c] = silu_f(cv);
    }
    if (tid < 4) {
        const float a = ba[(row0 + tid) * 32 + 16 + hvg], bb = ba[(row0 + tid) * 32 + hvg];
        float g = -__expf(P.in[19][hvg]) * softplus_f(a + P.in[20][hvg]);
        float t1 = __shfl_up(g, 1); if (tid >= 1) g += t1;
        float t2 = __shfl_up(g, 2); if (tid >= 2) g += t2;
        Gs[tid] = g; Bs[tid] = sigmoid_f(bb); }
    lds_sync();
    { const int mat = w >> 2, t = w & 3; lf_t p = (mat ? ks : qs) + t * 128;
      const float a = p[lane], c = p[lane + 64]; float ss = a * a + c * c;
#pragma unroll
      for (int o = 32; o >= 1; o >>= 1) ss += __shfl_xor(ss, o);
      const float rn = rsqrtf(ss + EPS) * (mat == 0 ? 0.08838834764831845f : 1.f);
      p[lane] = a * rn; p[lane + 64] = c * rn; }
    lds_sync();
    { const int p = tid >> 4, l = tid & 15, kind = p >> 4, i = (p >> 2) & 3, j = p & 3; lf_t xa = (kind ? qs : ks) + i * 128; float s = 0.f;
      for (int c = l; c < 128; c += 16) s += xa[c] * ks[j * 128 + c];
      s += __shfl_xor(s, 8); s += __shfl_xor(s, 4); s += __shfl_xor(s, 2); s += __shfl_xor(s, 1);
      if (l == 0) (kind ? qkd : kkd)[i * 4 + j] = s; }
    lds_sync();
    if (tid < 128) { const int c = tid; float u[4], ww[4];
#pragma unroll
        for (int i = 0; i < 4; ++i) { float ru = vs[i * 128 + c] * Bs[i], rw = ks[i * 128 + c] * Bs[i] * __expf(Gs[i]);
#pragma unroll
            for (int j = 0; j < 4; ++j) if (j < i) { const float l = Bs[i] * kkd[i * 4 + j] * __expf(Gs[i] - Gs[j]); ru -= l * u[j]; rw -= l * ww[j]; }
            u[i] = ru; ww[i] = rw; us[i * 128 + c] = ru; wsm[i * 128 + c] = rw; } }
    lds_sync();
    const int c4 = tid & 31, dg = tid >> 5;
    const size_t sbase = ((size_t)(b * 16 + hvg) * 128 + dg * 8) * 128 + c4 * 4;
    f32x4 S[8];
    { const float* Sin = P.in[3] + sbase; f32x4 pw[4], pq[4];
#pragma unroll
      for (int i = 0; i < 4; ++i) { pw[i] = (f32x4){0.f, 0.f, 0.f, 0.f}; pq[i] = (f32x4){0.f, 0.f, 0.f, 0.f}; }
#pragma unroll
      for (int dd = 0; dd < 8; ++dd) S[dd] = __builtin_nontemporal_load((const f32x4*)(Sin + dd * 128));
#pragma unroll
      for (int dd = 0; dd < 8; ++dd) { const int dk = dg * 8 + dd;
#pragma unroll
          for (int i = 0; i < 4; ++i) { pw[i] += S[dd] * wsm[i * 128 + dk]; pq[i] += S[dd] * qs[i * 128 + dk]; } }
#pragma unroll
      for (int i = 0; i < 4; ++i) { *(LAS f32x4*)(redp + (dg * 8 + i) * 128 + c4 * 4) = pw[i]; *(LAS f32x4*)(redp + (dg * 8 + 4 + i) * 128 + c4 * 4) = pq[i]; } }
    lds_sync();
#pragma unroll
    for (int e = 0; e < 2; ++e) { const int idx = tid + e * 512; float s = 0.f;
#pragma unroll
        for (int g = 0; g < 16; ++g) s += redp[g * 1024 + idx];
        red[idx] = s; }
    lds_sync();
    if (tid < 128) { const int dv = tid; float v[4];
#pragma unroll
        for (int i = 0; i < 4; ++i) { v[i] = us[i * 128 + dv] - red[i * 128 + dv]; vn[i * 128 + dv] = v[i]; }
#pragma unroll
        for (int i = 0; i < 4; ++i) { float o = __expf(Gs[i]) * red[(4 + i) * 128 + dv];
#pragma unroll
            for (int j = 0; j < 4; ++j) if (j <= i) o += qkd[i * 4 + j] * __expf(Gs[i] - Gs[j]) * v[j];
            on[i * 128 + dv] = o; } }
    lds_sync();
    { float* Sout = P.out + O_GDNS + sbase; const float eg = __expf(Gs[3]); f32x4 vv[4];
#pragma unroll
      for (int j = 0; j < 4; ++j) vv[j] = *(LAS f32x4*)(vn + j * 128 + c4 * 4) * __expf(Gs[3] - Gs[j]);
#pragma unroll
      for (int dd = 0; dd < 8; ++dd) { const int dk = dg * 8 + dd; f32x4 sn = S[dd] * eg;
#pragma unroll
          for (int j = 0; j < 4; ++j) sn += vv[j] * ks[j * 128 + dk];
          __builtin_nontemporal_store(sn, (f32x4*)(Sout + dd * 128)); } }
    if (w < 4) { const int i = w; const float a = on[i * 128 + lane], c = on[i * 128 + lane + 64]; float ss = a * a + c * c;
#pragma unroll
        for (int o = 32; o >= 1; o >>= 1) ss += __shfl_xor(ss, o);
        const float rn = rsqrtf(ss * (1.f / 128.f) + EPS);
        const bf16_t* zp = proj + (row0 + i) * 6144 + 4096 + hvg * 128; bf16_t* op = og + (row0 + i) * 2048 + hvg * 128;
        op[lane] = f2bf(a * rn * P.in[21][lane] * silu_f(bf2f(zp[lane]))); op[lane + 64] = f2bf(c * rn * P.in[21][lane + 64] * silu_f(bf2f(zp[lane + 64]))); }
    lds_sync();
}

__device__ __forceinline__ void phase_gdn_prep(const Params& P, lds_t lds, int bid, int nb, int tid) {
    asm volatile("" : "+v"(tid));
    GaPre R;
    if (bid < 2048) gdn_prep_load(P, bid, tid, R);
    for (int t = bid; t < 2048; t += nb) gdn_prep_task(P, t, t + nb, lds, tid, R);
}
__device__ __forceinline__ void phase_gdn_scan(const Params& P, lds_t lds, int bid, int nb, int tid) {
    if (nb >= 256) {
        if (bid < 128) { for (int rep = 0; rep < ((SUBREP & 1) ? 2 : 1); ++rep) gdn_scan_task(P, bid, lds, tid); }
        else for (int rep = 0; rep < ((SUBREP & 2) ? 2 : 1); ++rep) for (int t = bid - 128; t < 2048; t += nb - 128) gdn_sample_task(P, t, lds, tid);
    } else {
        for (int t = bid; t < 128; t += nb) gdn_scan_task(P, t, lds, tid);
        for (int t = bid; t < 2048; t += nb) gdn_sample_task(P, t, lds, tid);
    }
}

#ifndef PHMASK
#define PHMASK 0x1fffffu
#endif
constexpr int NPH = 21;
__global__ void __launch_bounds__(512) fwd(Params P) {
    extern __shared__ __attribute__((aligned(16))) unsigned char lds_raw[];
    lds_t lds = (lds_t)lds_raw;
    cg::grid_group grid = cg::this_grid();
    const int bid = blockIdx.x, nb = gridDim.x, tid = threadIdx.x;
    unsigned char* ws = P.ws;
    const float* mod = (const float*)(ws + WS_MOD);
    bf16_t* H = (bf16_t*)(ws + WS_H); float* XA = (float*)(ws + WS_XA); float* XB = (float*)(ws + WS_XB);
    bf16_t* PROJ = (bf16_t*)(ws + WS_PROJ); bf16_t* OG = (bf16_t*)(ws + WS_OG);
    const int lo = P.ph_lo, hi = P.ph_hi;
    volatile LAS unsigned* xst = (volatile LAS unsigned*)(lds + LDS_BYTES - 16);
    if (tid < 4) xst[tid] = 0u;
    __syncthreads();
    const XcdBarrier xbar = xcd_barrier_post((unsigned*)(ws + WS_CTL), xst);
#define SEAM(k) if ((k) + 1 < hi) { xcd_barrier(xbar); }
    if (lo < 0) grid.sync();
#ifndef REPMASK
#define REPMASK 0u
#endif
    if (lo <= 0 && 0 < hi) { if constexpr ((PHMASK >> 0) & 1u) { phase_prep(P, lds, bid, nb, tid); } SEAM(0) }
    if (lo <= 1 && 1 < hi) { if constexpr ((PHMASK >> 1) & 1u) { { pg8::EpiF32 E{(float*)(ws + WS_MOD), MODN, (const float*)(ws + WS_MODB)}; if (nb >= 128) { if (bid < 56) run_gemm(lds, (const bf16_t*)(ws + WS_CS), (const bf16_t*)(ws + WS_WT_ADA), 256, MODN, 1024, E, bid, 56); else phase_prep_b(P, lds, bid - 56, nb - 56, tid); } else { run_gemm(lds, (const bf16_t*)(ws + WS_CS), (const bf16_t*)(ws + WS_WT_ADA), 256, MODN, 1024, E, bid, nb); phase_prep_b(P, lds, bid, nb, tid); } } } SEAM(1) }
    if (lo <= 2 && 2 < hi) { if constexpr ((PHMASK >> 2) & 1u) { phase_adaln(P, P.in[0], P.in[1], P.in[12], 0, 1024, H, nullptr, nullptr, bid, nb, tid); } SEAM(2) }
    if (lo <= 3 && 3 < hi) { if constexpr ((PHMASK >> 3) & 1u) { { pg8::EpiBf16<0> E{PROJ, 6144, nullptr, 0, 0}; run_gemm(lds, H, (const bf16_t*)(ws + WS_WT_RET_IN), MT, 6144, 1024, E, bid, nb); if (nb > 96) { if (bid >= 48) phase_prep_c(P, lds, bid - 48, nb - 48, tid); } else phase_prep_c(P, lds, bid, nb, tid); } } SEAM(3) }
    if (lo <= 4 && 4 < hi) { if constexpr ((PHMASK >> 4) & 1u) { phase_retention(P, lds, bid, nb, tid); } SEAM(4) }
    if (lo <= 5 && 5 < hi) { if constexpr ((PHMASK >> 5) & 1u) { phase_post_ret(P, bid, nb, tid); } SEAM(5) }
    if (lo <= 6 && 6 < hi) { if constexpr ((PHMASK >> 6) & 1u) { { EpiResid E{P.in[0], P.in[1], XA, mod + 2048}; if constexpr ((SUBREP & 64) != 0) { EpiNull EN{(float*)(ws + WS_CTL + 8192)}; run_gemm(lds, OG, (const bf16_t*)(ws + WS_WT_RET_OUT), MP, 1024, 2048, EN, bid, nb); } run_gemm(lds, OG, (const bf16_t*)(ws + WS_WT_RET_OUT), MP, 1024, 2048, E, bid, nb); resid_sample_pieces<2048>(OG, (const bf16_t*)(ws + WS_WT_RET_OUT), E, lds, bid, nb, tid); } } SEAM(6) }
    if (lo <= 7 && 7 < hi) { if constexpr ((PHMASK >> 7) & 1u) { phase_adaln(P, XA, XA + (size_t)MP * 1024, P.in[13], 3072, 4096, H, nullptr, nullptr, bid, nb, tid); } SEAM(7) }
    if (lo <= 8 && 8 < hi) { if constexpr ((PHMASK >> 8) & 1u) { { EpiUp E{(bf16_t*)(ws + WS_U), P.out + O_FCP, P.out + O_FCS, (bf16_t*)(ws + WS_ACT), (float*)(ws + WS_SIDEG), (float*)(ws + WS_SIDEV), P.in[24], P.in[25]}; run_gemm(lds, H, (const bf16_t*)(ws + WS_WT_UP), MT, 5632, 1024, E, bid, nb); if (nb > 200) { if (bid >= 172) phase_prep_d(P, lds, bid - 172, nb - 172, tid); } else phase_prep_d(P, lds, bid, nb, tid); } } SEAM(8) }
    if (lo <= 9 && 9 < hi) { if constexpr ((PHMASK >> 9) & 1u) { phase_act(P, 0, bid, nb, tid); } SEAM(9) }
    if (lo <= 10 && 10 < hi) { if constexpr ((PHMASK >> 10) & 1u) { { EpiResid E{XA, XA + (size_t)MP * 1024, XB, mod + 5120}; if constexpr ((SUBREP & 64) != 0) { EpiNull EN{(float*)(ws + WS_CTL + 8192)}; run_gemm(lds, (const bf16_t*)(ws + WS_ACT), (const bf16_t*)(ws + WS_WT_DOWN), MP, 1024, 2816, EN, bid, nb); } run_gemm(lds, (const bf16_t*)(ws + WS_ACT), (const bf16_t*)(ws + WS_WT_DOWN), MP, 1024, 2816, E, bid, nb); resid_sample_pieces<2816>((const bf16_t*)(ws + WS_ACT), (const bf16_t*)(ws + WS_WT_DOWN), E, lds, bid, nb, tid); } } SEAM(10) }
    if (lo <= 11 && 11 < hi) { if constexpr ((PHMASK >> 11) & 1u) { phase_adaln(P, XB, XB + (size_t)MP * 1024, P.in[12] + 1024, 6144, 6144 + 1024, H, nullptr, nullptr, bid, nb, tid); } SEAM(11) }
    if (lo <= 12 && 12 < hi) { if constexpr ((PHMASK >> 12) & 1u) { { EpiGdnIn E{PROJ, (float*)(ws + WS_BA), P.out + O_GCP, P.out + O_GCS}; run_gemm(lds, H, (const bf16_t*)(ws + WS_WT_GDN_IN), MT, 6400, 1024, E, bid, nb); } } SEAM(12) }
    if (lo <= 13 && 13 < hi) { if constexpr ((PHMASK >> 13) & 1u) { phase_gdn_prep(P, lds, bid, nb, tid); } SEAM(13) }
    if (lo <= 14 && 14 < hi) { if constexpr ((PHMASK >> 14) & 1u) { phase_gdn_scan(P, lds, bid, nb, tid); } SEAM(14) }
    if (lo <= 15 && 15 < hi) { if constexpr ((PHMASK >> 15) & 1u) { { EpiResid E{XB, XB + (size_t)MP * 1024, XA, mod + 6144 + 2048}; run_gemm(lds, OG, (const bf16_t*)(ws + WS_WT_GDN_OUT), MP, 1024, 2048, E, bid, nb); resid_sample_pieces<2048>(OG, (const bf16_t*)(ws + WS_WT_GDN_OUT), E, lds, bid, nb, tid); } } SEAM(15) }
    if (lo <= 16 && 16 < hi) { if constexpr ((PHMASK >> 16) & 1u) { phase_adaln(P, XA, XA + (size_t)MP * 1024, P.in[13] + 1024, 6144 + 3072, 6144 + 4096, H, nullptr, nullptr, bid, nb, tid); } SEAM(16) }
    if (lo <= 17 && 17 < hi) { if constexpr ((PHMASK >> 17) & 1u) { { EpiUp E{(bf16_t*)(ws + WS_U), P.out + O_FCP + (size_t)8 * 2 * 2816, P.out + O_FCS + (size_t)128 * 2 * 2816, (bf16_t*)(ws + WS_ACT), (float*)(ws + WS_SIDEG), (float*)(ws + WS_SIDEV), P.in[24] + (size_t)3 * 2816, P.in[25] + 2816}; run_gemm(lds, H, (const bf16_t*)(ws + WS_WT_UP) + (size_t)5632 * 1024, MT, 5632, 1024, E, bid, nb); } } SEAM(17) }
    if (lo <= 18 && 18 < hi) { if constexpr ((PHMASK >> 18) & 1u) { phase_act(P, 1, bid, nb, tid); } SEAM(18) }
    if (lo <= 19 && 19 < hi) { if constexpr ((PHMASK >> 19) & 1u) { { EpiResid E{XA, XA + (size_t)MP * 1024, XB, mod + 6144 + 5120}; run_gemm(lds, (const bf16_t*)(ws + WS_ACT), (const bf16_t*)(ws + WS_WT_DOWN) + (size_t)1024 * 2816, MP, 1024, 2816, E, bid, nb); resid_sample_pieces<2816>((const bf16_t*)(ws + WS_ACT), (const bf16_t*)(ws + WS_WT_DOWN) + (size_t)1024 * 2816, E, lds, bid, nb, tid); } } SEAM(19) }
    if (lo <= 20 && 20 < hi) { if constexpr ((PHMASK >> 20) & 1u) { phase_adaln(P, XB, XB + (size_t)MP * 1024, P.in[14], 12288, 12288 + 1024, nullptr, P.out + O_YP, P.out + O_YS, bid, nb, tid); } SEAM(20) }
}

#ifndef ONE_LAUNCH
#ifdef REPMASK_SET
#define ONE_LAUNCH 0
#else
#define ONE_LAUNCH 1
#endif
#endif
extern "C" void kernel_launch(void* const* d_in, const int* in_sizes, int n_in, void* d_out, int out_size, void* d_ws, size_t ws_size, hipStream_t stream) {
    static int grid_blocks = 0;
    if (!grid_blocks) {
        int dev = 0, cus = 0, per_cu = 0;
        hipGetDevice(&dev);
        hipDeviceGetAttribute(&cus, hipDeviceAttributeMultiprocessorCount, dev);
        hipFuncSetAttribute((const void*)fwd, hipFuncAttributeMaxDynamicSharedMemorySize, LDS_BYTES);
        hipOccupancyMaxActiveBlocksPerMultiprocessor(&per_cu, (const void*)fwd, 512, LDS_BYTES);
        if (per_cu < 1) { fprintf(stderr, "occupancy query says %d blocks per CU\n", per_cu); per_cu = 1; }
        grid_blocks = cus;
        if (ws_size < WS_END) fprintf(stderr, "workspace too small: %zu < %zu\n", ws_size, (size_t)WS_END);
    }
    Params p{};
    hipMemsetAsync((char*)d_ws + WS_CTL, 0, XCD_BAR_WORDS * 4, stream);
    for (int i = 0; i < 27; ++i) p.in[i] = (const float*)d_in[i];
    p.out = (float*)d_out; p.ws = (unsigned char*)d_ws;
#if ONE_LAUNCH
    p.ph_lo = 0; p.ph_hi = NPH;
#ifdef RT_REP
    p.rep = RT_REP;
#endif
    { void* args[] = {&p}; hipError_t e = hipLaunchCooperativeKernel((void*)fwd, dim3(grid_blocks), dim3(512), args, LDS_BYTES, stream);
      if (e != hipSuccess) fprintf(stderr, "cooperative launch failed: %s (grid %d)\n", hipGetErrorString(e), grid_blocks); }
#else
    for (int ph = 0; ph < NPH; ++ph) { p.ph_lo = ph; p.ph_hi = ph + 1; const int nrep = ((REPMASK >> ph) & 1u) ? 2 : 1;
        for (int r = 0; r < nrep; ++r) hipLaunchKernelGGL(fwd, dim3(grid_blocks), dim3(512), LDS_BYTES, stream, p); }
#endif
}
```

```cpp
#include <hip/hip_runtime.h>
#include <hip/hip_cooperative_groups.h>
#include <cstdio>
namespace cg = cooperative_groups;
namespace pg8 {
#define PG8_LAS __attribute__((address_space(3)))
typedef unsigned short bf16_t;
typedef short bf16x8 __attribute__((ext_vector_type(8)));
typedef float f32x4 __attribute__((ext_vector_type(4)));
typedef unsigned u32x4 __attribute__((ext_vector_type(4)));
constexpr int BM = 256, BK = 64, HALF = 128, HTB = HALF * BK * 2  , STAGE_BYTES = 8 * HTB, NXCD = 8, WGM = 8;

__host__ __device__ __forceinline__ int lds_byte(int r, int c) { const int st = (r >> 4) * 2 + (c >> 5), rr = r & 15, cc = c & 31, ob = rr * 64 + cc * 2; return st * 1024 + (ob ^ (((ob >> 9) & 1) << 5)); }
__host__ __device__ __forceinline__ void stage_rc(int b, int& R, int& C) { const int st = b / 1024, sb = b % 1024, swz = sb ^ (((sb >> 9) & 1) << 5); R = (st >> 1) * 16 + swz / 64; C = (st & 1) * 32 + (swz % 64) / 2; }
__host__ __device__ __forceinline__ int perm32(int rho) { const int n = rho >> 4, i = rho & 15; return 8 * (i >> 2) + 4 * n + (i & 3); }

struct Unit { int pm, pn; };
struct Gemm { const bf16_t* A; const bf16_t* Bt; int M, N, K; };

struct StaticOrder {
    int nM, nN, nwg, G, c;
    __host__ __device__ void init(int M, int N, int G_, int c_) { nM = M / BM; nN = N / BM; nwg = nM * nN; G = G_; c = c_; }
    __host__ __device__ bool next(int i, Unit& u) const {
        const long L = (long)i * G + c; if (L >= nwg) return false;
        int wgid = (int)L; { const int q = nwg / NXCD, r = nwg % NXCD, xcd = wgid % NXCD, off = wgid / NXCD; wgid = (xcd < r ? xcd * (q + 1) : r * (q + 1) + (xcd - r) * q) + off; }
        const int nig = WGM * nN, gid = wgid / nig, fm = gid * WGM, gsz = (nM - fm) < WGM ? (nM - fm) : WGM;
        u.pm = fm + ((wgid % nig) % gsz); u.pn = (wgid % nig) / gsz; return true;
    }
    __device__ __forceinline__ void a_ready(const Unit&) const {}
    __device__ __forceinline__ void done(const Unit&) const {}
};
struct CountedOrder : StaticOrder {
    const unsigned* ready; unsigned need; unsigned* tmo;
    __device__ __forceinline__ void a_ready(const Unit& u) const {
        if (threadIdx.x < 64) {
            const unsigned long long t0 = __builtin_amdgcn_s_memrealtime(); unsigned polls = 0;
            while ((unsigned)__builtin_amdgcn_readfirstlane(__hip_atomic_load(ready + 64 * u.pm, __ATOMIC_RELAXED, __HIP_MEMORY_SCOPE_AGENT)) < need) {
                if ((++polls & 255u) == 0u && __builtin_amdgcn_readfirstlane(__hip_atomic_load(tmo, __ATOMIC_RELAXED, __HIP_MEMORY_SCOPE_AGENT)) != 0u) break;
                if (__builtin_amdgcn_s_memrealtime() - t0 > 2000000ull) {
                    if (threadIdx.x == 0) { unsigned expect = 0u; __hip_atomic_compare_exchange_strong(tmo + 1, &expect, 0x600u | (unsigned)(u.pm & 0xff), __ATOMIC_RELAXED, __ATOMIC_RELAXED, __HIP_MEMORY_SCOPE_AGENT); __hip_atomic_store(tmo, 1u, __ATOMIC_RELAXED, __HIP_MEMORY_SCOPE_AGENT); }
                    break; }
                __builtin_amdgcn_s_sleep(2); }
            __builtin_amdgcn_fence(__ATOMIC_ACQUIRE, "agent");
            asm volatile("s_waitcnt vmcnt(0)" ::: "memory");
        }
#if !defined(BROKEN_HOOK_NO_BARRIER)
        asm volatile("" ::: "memory"); __builtin_amdgcn_s_barrier(); asm volatile("" ::: "memory");
#endif
    }
};

__device__ __forceinline__ unsigned cvt_pk_bf16(float lo, float hi) { unsigned r; asm volatile("v_cvt_pk_bf16_f32 %0, %1, %2" : "=v"(r) : "v"(lo), "v"(hi)); return r; }
typedef float f32x2 __attribute__((ext_vector_type(2)));
__device__ __forceinline__ f32x2 gelu_pk(f32x2 v) {
    const f32x2 av = __builtin_elementwise_abs(v), d = av * 0.2316418882f + 1.0f;
    f32x2 t; t.x = __builtin_amdgcn_rcpf(d.x); t.y = __builtin_amdgcn_rcpf(d.y);
    f32x2 q = t * 0.5307027145f + (-0.7265760135f); q = q * t + 0.7107068705f; q = q * t + (-0.142248368f); q = q * t + 0.127414796f; q = q * t;
    const f32x2 s = (v * v) * (-0.72134752044f);
    f32x2 e; e.x = __builtin_amdgcn_exp2f(s.x); e.y = __builtin_amdgcn_exp2f(s.y);
    const f32x2 m = v * (q * e), r = v - m;
    f32x2 o; o.x = v.x < 0.f ? m.x : r.x; o.y = v.y < 0.f ? m.y : r.y; return o;
}

struct EpiF32 {
    static constexpr bool PERM = false, AFTER_DRAIN = false;
    float* C; int ldc; const float* bias;
    __device__ __forceinline__ void operator()(const f32x4 (&acc)[2][2][4][2], const Unit& u, int wr, int wc, int fr, int fq) const {
        const int row0 = u.pm * BM + wr * 64 + fr, col0 = u.pn * BM + wc * 32 + 4 * fq;
        f32x4 bv[2][2];
#pragma unroll
        for (int bj = 0; bj < 2; ++bj)
#pragma unroll
            for (int n = 0; n < 2; ++n) bv[bj][n] = bias ? *(const f32x4*)(bias + col0 + bj * HALF + n * 16) : (f32x4){0.f, 0.f, 0.f, 0.f};
#pragma unroll
        for (int ai = 0; ai < 2; ++ai)
#pragma unroll
            for (int m = 0; m < 4; ++m) { float* rowp = C + (size_t)(row0 + ai * HALF + m * 16) * ldc + col0;
#pragma unroll
                for (int bj = 0; bj < 2; ++bj)
#pragma unroll
                    for (int n = 0; n < 2; ++n) *(f32x4*)(rowp + bj * HALF + n * 16) = acc[ai][bj][m][n] + bv[bj][n]; }
    }
};
template <int ACT  > struct EpiBf16 {
    static constexpr bool PERM = true, AFTER_DRAIN = false;
    bf16_t* O; int ldc; const float* bias; int split_cols; size_t split_stride;
    __device__ __forceinline__ void operator()(const f32x4 (&acc)[2][2][4][2], const Unit& u, int wr, int wc, int fr, int fq) const {
        const int row0 = u.pm * BM + wr * 64 + fr; int colt = u.pn * BM; bf16_t* base = O;
        if (split_cols) { const int t = colt / split_cols; base += (size_t)t * split_stride; colt -= t * split_cols; }
        const int col0 = colt + wc * 32 + 8 * fq, bcol0 = u.pn * BM + wc * 32 + 8 * fq;
        f32x4 bv[2][2];
#pragma unroll
        for (int bj = 0; bj < 2; ++bj)
#pragma unroll
            for (int n = 0; n < 2; ++n) bv[bj][n] = bias ? *(const f32x4*)(bias + bcol0 + bj * HALF + 4 * n) : (f32x4){0.f, 0.f, 0.f, 0.f};
#pragma unroll
        for (int ai = 0; ai < 2; ++ai)
#pragma unroll
            for (int m = 0; m < 4; ++m) { bf16_t* rowp = base + (size_t)(row0 + ai * HALF + m * 16) * ldc + col0;
#pragma unroll
                for (int bj = 0; bj < 2; ++bj) { f32x4 v0 = acc[ai][bj][m][0] + bv[bj][0], v1 = acc[ai][bj][m][1] + bv[bj][1];
                    if (ACT == 1) { f32x2 a = gelu_pk((f32x2){v0[0], v0[1]}), b = gelu_pk((f32x2){v0[2], v0[3]}), c = gelu_pk((f32x2){v1[0], v1[1]}), d = gelu_pk((f32x2){v1[2], v1[3]});
                        v0 = (f32x4){a.x, a.y, b.x, b.y}; v1 = (f32x4){c.x, c.y, d.x, d.y}; }
                    if (ACT == 2) {
#pragma unroll
                        for (int j = 0; j < 4; ++j) { v0[j] = 0.5f * v0[j] * (1.0f + erff(v0[j] * 0.70710678f)); v1[j] = 0.5f * v1[j] * (1.0f + erff(v1[j] * 0.70710678f)); } }
                    u32x4 w; w.x = cvt_pk_bf16(v0[0], v0[1]); w.y = cvt_pk_bf16(v0[2], v0[3]); w.z = cvt_pk_bf16(v1[0], v1[1]); w.w = cvt_pk_bf16(v1[2], v1[3]);
                    *(u32x4*)(rowp + bj * HALF) = w; } }
    }
};

struct PanelStats {
    unsigned* xbuf;
    unsigned* cnt;
    unsigned* tmo;
    int ntn; float eps;
    unsigned code;
    __device__ __forceinline__ bool run(const f32x4 (&v)[2][2][4][2], const Unit& u, int wr, int wc, int fr, int fq, PG8_LAS unsigned char* lds, int wid, int lane) const {
        typedef float f32x2v __attribute__((ext_vector_type(2)));
        PG8_LAS f32x2v* P = (PG8_LAS f32x2v*)lds;
        PG8_LAS f32x2v* S = (PG8_LAS f32x2v*)(lds + 8192);
        PG8_LAS unsigned* flag = (PG8_LAS unsigned*)(lds + 8192 + 2048);
#pragma unroll
        for (int ai = 0; ai < 2; ++ai)
#pragma unroll
            for (int m = 0; m < 4; ++m) {
                float s = 0.f;
#pragma unroll
                for (int bj = 0; bj < 2; ++bj)
#pragma unroll
                    for (int n = 0; n < 2; ++n) { const f32x4 x = v[ai][bj][m][n]; s += (x[0] + x[1]) + (x[2] + x[3]); }
                s += __shfl_xor(s, 16); s += __shfl_xor(s, 32);
                const float mw = s * (1.0f / 64.0f); float q = 0.f;
#pragma unroll
                for (int bj = 0; bj < 2; ++bj)
#pragma unroll
                    for (int n = 0; n < 2; ++n) { const f32x4 d = v[ai][bj][m][n] - mw; q += (d[0] * d[0] + d[1] * d[1]) + (d[2] * d[2] + d[3] * d[3]); }
                q += __shfl_xor(q, 16); q += __shfl_xor(q, 32);
                if (fq == 0) P[(ai * HALF + wr * 64 + m * 16 + fr) * 4 + wc] = (f32x2v){mw, q};
            }
        asm volatile("s_waitcnt lgkmcnt(0)" ::: "memory"); __builtin_amdgcn_s_barrier(); asm volatile("" ::: "memory");
#if defined(BROKEN_NO_WAIT)
        if (blockIdx.x >= 64) { const long long t0 = clock64(); while (clock64() - t0 < 60000) __builtin_amdgcn_s_sleep(8); }
#endif
        const int row = wid * 32 + (lane & 31);
        if (lane < 32) {
            const f32x2v a = P[row * 4 + 0], b = P[row * 4 + 1], c = P[row * 4 + 2], d = P[row * 4 + 3];
            const float mt = (a.x + b.x + c.x + d.x) * 0.25f;
            const float da = a.x - mt, db = b.x - mt, dc = c.x - mt, dd = d.x - mt;
            const float m2 = (a.y + b.y) + (c.y + d.y) + 64.0f * ((da * da + db * db) + (dc * dc + dd * dd));
            unsigned long long* slot = (unsigned long long*)xbuf + ((size_t)(u.pm * BM + row) * 4 + u.pn);
            __hip_atomic_store(slot, ((unsigned long long)__float_as_uint(m2) << 32) | __float_as_uint(mt), __ATOMIC_RELAXED, __HIP_MEMORY_SCOPE_AGENT);
        }
        asm volatile("s_waitcnt vmcnt(0)" ::: "memory");
        if (lane == 0) __hip_atomic_fetch_add(cnt + 64 * u.pm, 1u, __ATOMIC_RELAXED, __HIP_MEMORY_SCOPE_AGENT);
        if (wid == 0) {
            bool dead = false; const unsigned long long t0 = __builtin_amdgcn_s_memrealtime(); const unsigned want = 8u * (unsigned)ntn;
            for (;;) {
#if defined(BROKEN_NO_WAIT)
                break;
#endif
                if ((unsigned)__builtin_amdgcn_readfirstlane(__hip_atomic_load(cnt + 64 * u.pm, __ATOMIC_RELAXED, __HIP_MEMORY_SCOPE_AGENT)) >= want) break;
                if (__builtin_amdgcn_s_memrealtime() - t0 > 2000000ull) {
                    if (lane == 0) { unsigned expect = 0u; __hip_atomic_compare_exchange_strong(tmo + 1, &expect, code | (unsigned)(u.pm & 0xff), __ATOMIC_RELAXED, __ATOMIC_RELAXED, __HIP_MEMORY_SCOPE_AGENT);
                                     __hip_atomic_store(tmo, 1u, __ATOMIC_RELAXED, __HIP_MEMORY_SCOPE_AGENT); }
                    dead = true; break; }
                __builtin_amdgcn_s_sleep(2);
            }
            __builtin_amdgcn_fence(__ATOMIC_ACQUIRE, "agent");
            if (lane == 0) flag[0] = dead ? 1u : 0u;
        }
        asm volatile("s_waitcnt vmcnt(0) lgkmcnt(0)" ::: "memory"); __builtin_amdgcn_s_barrier(); asm volatile("" ::: "memory");
        const bool bad = flag[0] != 0u;
        if (lane < 32) {
            const unsigned long long* slot = (const unsigned long long*)xbuf + (size_t)(u.pm * BM + row) * 4; float mt[4], m2[4]; float ms = 0.f;
#pragma unroll
            for (int t = 0; t < 4; ++t) { if (t < ntn) { const unsigned long long w = __hip_atomic_load(slot + t, __ATOMIC_RELAXED, __HIP_MEMORY_SCOPE_AGENT); mt[t] = __uint_as_float((unsigned)w); m2[t] = __uint_as_float((unsigned)(w >> 32)); } else { mt[t] = 0.f; m2[t] = 0.f; } ms += mt[t]; }
            const float mean = ms / (float)ntn; float q = 0.f;
#pragma unroll
            for (int t = 0; t < 4; ++t) if (t < ntn) { const float dm = mt[t] - mean; q += m2[t] + 256.0f * dm * dm; }
            S[row] = (f32x2v){mean, 1.0f / sqrtf(q / (256.0f * (float)ntn) + eps)};
        }
        asm volatile("s_waitcnt lgkmcnt(0)" ::: "memory"); __builtin_amdgcn_s_barrier(); asm volatile("" ::: "memory");
        return bad;
    }
};
struct EpiLnRes {
    static constexpr bool PERM = false, AFTER_DRAIN = true;
    const float* base; float* out; int ldc; const float* bias; PanelStats st; unsigned poison;
    __device__ __forceinline__ void refuse(size_t i0, size_t stride, int M, int N) const { const float q = __builtin_nanf(""); for (size_t i = i0; i < (size_t)M * N; i += stride) out[(i / N) * ldc + i % N] = q;
        if (i0 == 0) { unsigned expect = 0u; __hip_atomic_compare_exchange_strong(st.tmo + 1, &expect, 0x7f0u, __ATOMIC_RELAXED, __ATOMIC_RELAXED, __HIP_MEMORY_SCOPE_AGENT); __hip_atomic_store(st.tmo, 1u, __ATOMIC_RELAXED, __HIP_MEMORY_SCOPE_AGENT); } }
    __device__ __forceinline__ void fused(f32x4 (&acc)[2][2][4][2], const Unit& u, int wr, int wc, int fr, int fq, PG8_LAS unsigned char* lds, int wid, int lane) const {
        typedef float f32x2v __attribute__((ext_vector_type(2)));
        const PG8_LAS f32x2v* S = (const PG8_LAS f32x2v*)(lds + 8192);
        const int col0 = u.pn * BM + wc * 32 + 4 * fq;
#pragma unroll
        for (int bj = 0; bj < 2; ++bj)
#pragma unroll
            for (int n = 0; n < 2; ++n) { const f32x4 bv = bias ? *(const f32x4*)(bias + col0 + bj * HALF + n * 16) : (f32x4){0.f, 0.f, 0.f, 0.f};
#pragma unroll
                for (int ai = 0; ai < 2; ++ai)
#pragma unroll
                    for (int m = 0; m < 4; ++m) acc[ai][bj][m][n] += bv; }
        const bool bad = st.run(acc, u, wr, wc, fr, fq, lds, wid, lane) || poison != 0u;
        const float qnan = __builtin_nanf("");
#pragma unroll
        for (int ai = 0; ai < 2; ++ai)
#pragma unroll
            for (int m = 0; m < 4; ++m) { const int r = ai * HALF + wr * 64 + m * 16 + fr; const f32x2v sr = S[r]; const size_t off = (size_t)(u.pm * BM + r) * ldc + col0;
#pragma unroll
                for (int bj = 0; bj < 2; ++bj)
#pragma unroll
                    for (int n = 0; n < 2; ++n) { const f32x4 bs = *(const f32x4*)(base + off + bj * HALF + n * 16); f32x4 o = bs + (acc[ai][bj][m][n] - sr.x) * sr.y;
                        if (bad) o = (f32x4){qnan, qnan, qnan, qnan}; *(f32x4*)(out + off + bj * HALF + n * 16) = o; }
                asm volatile("" ::: "memory"); }
    }
};
struct EpiLnResLn {
    static constexpr bool PERM = false, AFTER_DRAIN = true;
    const float* base; float* out; bf16_t* xn; int ldc; const float* bias; PanelStats st1, st2; unsigned poison;
    __device__ __forceinline__ void refuse(size_t i0, size_t stride, int M, int N) const { const float q = __builtin_nanf(""); for (size_t i = i0; i < (size_t)M * N; i += stride) { const size_t o = (i / N) * ldc + i % N; out[o] = q; xn[o] = (bf16_t)0x7fc0u; }
        if (i0 == 0) { unsigned expect = 0u; __hip_atomic_compare_exchange_strong(st1.tmo + 1, &expect, 0x7f0u, __ATOMIC_RELAXED, __ATOMIC_RELAXED, __HIP_MEMORY_SCOPE_AGENT); __hip_atomic_store(st1.tmo, 1u, __ATOMIC_RELAXED, __HIP_MEMORY_SCOPE_AGENT); } }
    __device__ __forceinline__ void fused(f32x4 (&acc)[2][2][4][2], const Unit& u, int wr, int wc, int fr, int fq, PG8_LAS unsigned char* lds, int wid, int lane) const {
        typedef float f32x2v __attribute__((ext_vector_type(2))); typedef unsigned u32x2v __attribute__((ext_vector_type(2)));
        const PG8_LAS f32x2v* S = (const PG8_LAS f32x2v*)(lds + 8192);
        const int col0 = u.pn * BM + wc * 32 + 4 * fq;
#pragma unroll
        for (int bj = 0; bj < 2; ++bj)
#pragma unroll
            for (int n = 0; n < 2; ++n) { const f32x4 bv = bias ? *(const f32x4*)(bias + col0 + bj * HALF + n * 16) : (f32x4){0.f, 0.f, 0.f, 0.f};
#pragma unroll
                for (int ai = 0; ai < 2; ++ai)
#pragma unroll
                    for (int m = 0; m < 4; ++m) acc[ai][bj][m][n] += bv; }
        bool bad = st1.run(acc, u, wr, wc, fr, fq, lds, wid, lane) || poison != 0u;
        const float qnan = __builtin_nanf("");
#pragma unroll
        for (int ai = 0; ai < 2; ++ai)
#pragma unroll
            for (int m = 0; m < 4; ++m) { const int r = ai * HALF + wr * 64 + m * 16 + fr; const f32x2v sr = S[r]; const size_t off = (size_t)(u.pm * BM + r) * ldc + col0;
#pragma unroll
                for (int bj = 0; bj < 2; ++bj)
#pragma unroll
                    for (int n = 0; n < 2; ++n) { const f32x4 bs = *(const f32x4*)(base + off + bj * HALF + n * 16); acc[ai][bj][m][n] = bs + (acc[ai][bj][m][n] - sr.x) * sr.y; }
                asm volatile("" : "+v"(acc[ai][0][m][0]), "+v"(acc[ai][0][m][1]), "+v"(acc[ai][1][m][0]), "+v"(acc[ai][1][m][1]));
                if (m & 1) asm volatile("" ::: "memory"); }
        const bool bad1 = bad;
        bad = st2.run(acc, u, wr, wc, fr, fq, lds, wid, lane) || bad;
#pragma unroll
        for (int ai = 0; ai < 2; ++ai)
#pragma unroll
            for (int m = 0; m < 4; ++m) { const int r = ai * HALF + wr * 64 + m * 16 + fr; const f32x2v sr = S[r]; const size_t off = (size_t)(u.pm * BM + r) * ldc + col0;
#pragma unroll
                for (int bj = 0; bj < 2; ++bj)
#pragma unroll
                    for (int n = 0; n < 2; ++n) { const f32x4 x1 = acc[ai][bj][m][n]; *(f32x4*)(out + off + bj * HALF + n * 16) = bad1 ? (f32x4){qnan, qnan, qnan, qnan} : x1;
                        const f32x4 o = (x1 - sr.x) * sr.y; u32x2v w; w.x = cvt_pk_bf16(o[0], o[1]); w.y = cvt_pk_bf16(o[2], o[3]);
                        if (bad) { w.x = 0x7fc07fc0u; w.y = 0x7fc07fc0u; } *(u32x2v*)(xn + off + bj * HALF + n * 16) = w; }
                asm volatile("" ::: "memory"); }
    }
};

template <class Epi, class Sched, bool STAMP = false>
__device__ __forceinline__ void gemm_phase(PG8_LAS unsigned char* lds, const Gemm g, const Sched& S, const Epi& E, unsigned long long* stamps) {
    const int tid = threadIdx.x, wid = __builtin_amdgcn_readfirstlane(tid >> 6), lane = tid & 63, wr = wid >> 2, wc = wid & 3, fr = lane & 15, fq = lane >> 4;
    const int K = g.K, nt = K / BK;
    int ts_lo = 0, ts_hi = 0, nts = 0; const unsigned long long rt_entry = STAMP ? (unsigned long long)wall_clock64() : 0ull;
#define PG8_STAMP() do { if (STAMP && wid == 0 && nts < 64) { const unsigned long long _c = (unsigned long long)clock64(); \
        ts_lo = (lane == nts) ? (int)(unsigned)_c : ts_lo; ts_hi = (lane == nts) ? (int)(unsigned)(_c >> 32) : ts_hi; ++nts; } } while (0)
    PG8_STAMP();
    unsigned voffA[2], voffB[2];
#pragma unroll
    for (int i = 0; i < 2; ++i) { int R, C; stage_rc(tid * 16 + i * 8192, R, C); const int Rb = Epi::PERM ? ((R & ~31) + perm32(R & 31)) : R;
        voffA[i] = (unsigned)(R * K + C) * 2u; voffB[i] = (unsigned)(Rb * K + C) * 2u; }
    const size_t kstep = (size_t)(BK * 2);
    const size_t hstep = (size_t)HALF * K * 2;
    const size_t tstep = 2 * hstep;
    const unsigned ldsw = (unsigned)wid * 1024u;
    const int aoff = lds_byte(wr * 64 + fr, fq * 8), boff = lds_byte(wc * 32 + fr, fq * 8);
#define PG8_SA(b, h) (((b) * 2 + (h)) * HTB)
#define PG8_SB(b, h) ((4 + (b) * 2 + (h)) * HTB)
#define PG8_STAGE(bufoff, gbase, voff) do { _Pragma("unroll") for (int _i = 0; _i < 2; ++_i) \
        __builtin_amdgcn_global_load_lds((const unsigned*)((const char*)(gbase) + (voff)[_i]), (PG8_LAS unsigned*)(lds + (bufoff) + ldsw + _i * 8192), 16, 0, 0); } while (0)
#define PG8_LDA(dst, b, h) do { _Pragma("unroll") for (int m = 0; m < 4; ++m) _Pragma("unroll") for (int k = 0; k < 2; ++k) dst[m][k] = *(const PG8_LAS bf16x8*)(lds + PG8_SA(b, h) + aoff + m * 2048 + k * 1024); } while (0)
#define PG8_LDB(dst, b, h) do { _Pragma("unroll") for (int n = 0; n < 2; ++n) _Pragma("unroll") for (int k = 0; k < 2; ++k) dst[n][k] = *(const PG8_LAS bf16x8*)(lds + PG8_SB(b, h) + boff + n * 2048 + k * 1024); } while (0)
#define PG8_MMA(ai, bj, At, Bt) do { __builtin_amdgcn_s_setprio(1); _Pragma("unroll") for (int m = 0; m < 4; ++m) _Pragma("unroll") for (int n = 0; n < 2; ++n) _Pragma("unroll") for (int k = 0; k < 2; ++k) \
        acc[ai][bj][m][n] = __builtin_amdgcn_mfma_f32_16x16x32_bf16(Bt[n][k], At[m][k], acc[ai][bj][m][n], 0, 0, 0); __builtin_amdgcn_s_setprio(0); } while (0)
#define PG8_WAIT_V(n) asm volatile("s_waitcnt vmcnt(" #n ")" ::: "memory")
#define PG8_WAIT_L(n) asm volatile("s_waitcnt lgkmcnt(" #n ")" ::: "memory")
#define PG8_BAR __builtin_amdgcn_s_barrier()
#define PG8_SCHED __builtin_amdgcn_sched_barrier(0)
    Unit cur, nxt; int ui = 0;
    if (!S.next(0, cur)) return;
    f32x4 acc[2][2][4][2];
#pragma unroll
    for (int a = 0; a < 2; ++a)
#pragma unroll
        for (int b = 0; b < 2; ++b)
#pragma unroll
            for (int m = 0; m < 4; ++m)
#pragma unroll
                for (int n = 0; n < 2; ++n) acc[a][b][m][n] = (f32x4){0.f, 0.f, 0.f, 0.f};
    bf16x8 At[4][2], B0[2][2], B1[2][2];
    const char* cA = (const char*)g.A + (size_t)cur.pm * tstep; const char* cB = (const char*)g.Bt + (size_t)cur.pn * tstep;
    S.a_ready(cur);
    PG8_STAGE(PG8_SB(0, 0), cB, voffB); PG8_STAGE(PG8_SA(0, 0), cA, voffA); PG8_STAGE(PG8_SB(0, 1), cB + hstep, voffB); PG8_STAGE(PG8_SA(0, 1), cA + hstep, voffA);
    if (wr == 1) PG8_BAR;
    PG8_WAIT_V(4); PG8_BAR;
    PG8_STAGE(PG8_SB(1, 0), cB + kstep, voffB); PG8_STAGE(PG8_SA(1, 0), cA + kstep, voffA); PG8_STAGE(PG8_SB(1, 1), cB + hstep + kstep, voffB);
    PG8_WAIT_V(6); PG8_BAR;
    PG8_STAMP();
    for (;;) {
        const bool has_next = S.next(ui + 1, nxt);
        const char* nA = has_next ? (const char*)g.A + (size_t)nxt.pm * tstep : cA; const char* nB = has_next ? (const char*)g.Bt + (size_t)nxt.pn * tstep : cB;
        for (int t = 0; t < nt; t += 2) {
            const bool last = (t == nt - 2);
            const char* a1 = cA + (size_t)(t + 1) * kstep;
            const char* a2 = last ? nA : cA + (size_t)(t + 2) * kstep; const char* b2 = last ? nB : cB + (size_t)(t + 2) * kstep;
            const char* a3 = a2 + kstep; const char* b3 = b2 + kstep;
            if (last && has_next) S.a_ready(nxt);
            PG8_LDB(B0, 0, 0); PG8_SCHED; PG8_LDA(At, 0, 0); PG8_STAGE(PG8_SA(1, 1), a1 + hstep, voffA);
            PG8_WAIT_L(8); PG8_BAR; PG8_WAIT_L(0); PG8_MMA(0, 0, At, B0); PG8_BAR; PG8_SCHED;
            PG8_LDB(B1, 0, 1); PG8_STAGE(PG8_SB(0, 0), b2, voffB);
            PG8_BAR; PG8_WAIT_L(0); PG8_MMA(0, 1, At, B1); PG8_BAR;
            PG8_LDA(At, 0, 1); PG8_STAGE(PG8_SA(0, 0), a2, voffA);
            PG8_BAR; PG8_WAIT_L(0); PG8_MMA(1, 0, At, B0); PG8_BAR; PG8_SCHED;
            PG8_STAGE(PG8_SB(0, 1), b2 + hstep, voffB);
            PG8_WAIT_V(6); PG8_BAR; PG8_MMA(1, 1, At, B1); PG8_BAR;
            PG8_LDB(B0, 1, 0); PG8_SCHED; PG8_LDA(At, 1, 0); PG8_STAGE(PG8_SA(0, 1), a2 + hstep, voffA);
            PG8_WAIT_L(8); PG8_BAR; PG8_WAIT_L(0); PG8_MMA(0, 0, At, B0); PG8_BAR; PG8_SCHED;
            PG8_LDB(B1, 1, 1); PG8_STAGE(PG8_SB(1, 0), b3, voffB);
            PG8_BAR; PG8_WAIT_L(0); PG8_MMA(0, 1, At, B1); PG8_BAR;
            PG8_LDA(At, 1, 1); PG8_STAGE(PG8_SA(1, 0), a3, voffA);
            PG8_BAR; PG8_WAIT_L(0); PG8_MMA(1, 0, At, B0); PG8_BAR; PG8_SCHED;
            PG8_STAGE(PG8_SB(1, 1), b3 + hstep, voffB);
            PG8_WAIT_V(6); PG8_BAR; PG8_MMA(1, 1, At, B1); PG8_BAR;
        }
        PG8_STAMP();
        if constexpr (!Epi::AFTER_DRAIN) { E(acc, cur, wr, wc, fr, fq); S.done(cur); }
        PG8_STAMP();
        if (!has_next) break;
#pragma unroll
        for (int a = 0; a < 2; ++a)
#pragma unroll
            for (int b = 0; b < 2; ++b)
#pragma unroll
                for (int m = 0; m < 4; ++m)
#pragma unroll
                    for (int n = 0; n < 2; ++n) acc[a][b][m][n] = (f32x4){0.f, 0.f, 0.f, 0.f};
        cur = nxt; cA = nA; cB = nB; ++ui;
    }
    PG8_WAIT_V(0);
    if (wr == 0) PG8_BAR;
    PG8_BAR;
    if constexpr (Epi::AFTER_DRAIN) { E.fused(acc, cur, wr, wc, fr, fq, lds, wid, lane); S.done(cur); }
    PG8_STAMP();
    if (STAMP && wid == 0) { stamps[lane] = lane < nts ? (((unsigned long long)(unsigned)ts_hi << 32) | (unsigned)ts_lo) : 0ull;
        if (lane == 62) stamps[62] = rt_entry; if (lane == 63) stamps[63] = (unsigned long long)wall_clock64(); }
#undef PG8_STAMP
#undef PG8_SA
#undef PG8_SB
#undef PG8_STAGE
#undef PG8_LDA
#undef PG8_LDB
#undef PG8_MMA
#undef PG8_WAIT_V
#undef PG8_WAIT_L
#undef PG8_BAR
#undef PG8_SCHED
}
}

using pg8::bf16_t; using pg8::bf16x8; using pg8::f32x4; using pg8::u32x4;
#define LAS __attribute__((address_space(3)))
typedef LAS unsigned char* lds_t;
typedef LAS bf16_t* lbf_t;
typedef LAS float* lf_t;
typedef unsigned u32x2 __attribute__((ext_vector_type(2)));

constexpr int MP = 16384, MSM = 512, MT = MP + MSM, MODN = 14336;
constexpr float EPS = 1e-6f;
constexpr size_t WS_WT_RET_IN = 0;
constexpr size_t WS_WT_RET_OUT = WS_WT_RET_IN + (size_t)6144 * 1024 * 2;
constexpr size_t WS_WT_GDN_IN = WS_WT_RET_OUT + (size_t)1024 * 2048 * 2;
constexpr size_t WS_WT_GDN_OUT = WS_WT_GDN_IN + (size_t)6400 * 1024 * 2;
constexpr size_t WS_WT_UP = WS_WT_GDN_OUT + (size_t)1024 * 2048 * 2;
constexpr size_t WS_WT_DOWN = WS_WT_UP + (size_t)2 * 5632 * 1024 * 2;
constexpr size_t WS_WT_ADA = WS_WT_DOWN + (size_t)2 * 1024 * 2816 * 2;
constexpr size_t WS_CS = WS_WT_ADA + (size_t)14336 * 1024 * 2;
constexpr size_t WS_MODB = WS_CS + (size_t)256 * 1024 * 2;
constexpr size_t WS_MOD = WS_MODB + (size_t)14336 * 4;
constexpr size_t WS_ROPE = WS_MOD + (size_t)256 * 14336 * 4;
constexpr size_t WS_XA = WS_ROPE + (size_t)2 * 2052 * 128 * 4;
constexpr size_t WS_XB = WS_XA + (size_t)MT * 1024 * 4;
constexpr size_t WS_H = WS_XB + (size_t)MT * 1024 * 4;
constexpr size_t WS_PROJ = WS_H + (size_t)MT * 1024 * 2;
constexpr size_t WS_BA = WS_PROJ + (size_t)MT * 6144 * 2;
constexpr size_t WS_OG = WS_BA + (size_t)MT * 32 * 4;
constexpr size_t WS_SSQ = WS_OG + (size_t)MT * 2048 * 2;
constexpr size_t WS_R2 = WS_SSQ + (size_t)MT * 64 * 4;
constexpr size_t GREC = 73728 + 256;
constexpr size_t WS_U = WS_R2;
constexpr size_t WS_ACT = WS_R2 + (size_t)MT * 5632 * 2;
constexpr size_t WS_ORAW = WS_R2;
constexpr size_t WS_CTL = WS_R2 + (size_t)4096 * GREC;
constexpr size_t WS_SIDEG = WS_CTL + 16384;
constexpr size_t WS_SIDEV = WS_SIDEG + (size_t)264 * 4 * 2816 * 4;
constexpr size_t WS_END = WS_SIDEV + (size_t)264 * 2 * 2816 * 4;
constexpr size_t O_YP = 0, O_YS = O_YP + (size_t)MP * 1024, O_RETP = O_YS + (size_t)MSM * 1024, O_GDNP = O_RETP + (size_t)8 * 4 * 256 * 512,
                 O_GCP = O_GDNP + (size_t)8 * 16 * 128 * 128, O_FCP = O_GCP + (size_t)8 * 3 * 4096, O_RETS = O_FCP + (size_t)2 * 8 * 2 * 2816,
                 O_GDNS = O_RETS + (size_t)128 * 4 * 256 * 512, O_GCS = O_GDNS + (size_t)128 * 16 * 128 * 128, O_FCS = O_GCS + (size_t)128 * 3 * 4096;
constexpr int LDS_BYTES = 160 * 1024;

struct Params { const float* in[27]; float* out; unsigned char* ws; int ph_lo, ph_hi, rep, pad; };

__device__ __forceinline__ float bf2f(bf16_t b) { return __uint_as_float(((unsigned)b) << 16); }
__device__ __forceinline__ float bflo(unsigned u) { return __uint_as_float(u << 16); }
__device__ __forceinline__ float bfhi(unsigned u) { return __uint_as_float(u & 0xffff0000u); }
typedef float f32x2_t __attribute__((ext_vector_type(2)));
typedef __bf16 bf16x2_t __attribute__((ext_vector_type(2)));
__device__ __forceinline__ unsigned pk2(float lo, float hi) { f32x2_t v = {lo, hi}; bf16x2_t b = __builtin_convertvector(v, bf16x2_t); return __builtin_bit_cast(unsigned, b); }
__device__ __forceinline__ bf16_t f2bf(float f) { return (bf16_t)(pk2(f, 0.f) & 0xffffu); }
__device__ __forceinline__ float silu_f(float x) { return x * __builtin_amdgcn_rcpf(1.f + __expf(-x)); }
__device__ __forceinline__ float sigmoid_f(float x) { return __builtin_amdgcn_rcpf(1.f + __expf(-x)); }
__device__ __forceinline__ void unpack8(const u32x4 v, float* f) { f[0] = bflo(v.x); f[1] = bfhi(v.x); f[2] = bflo(v.y); f[3] = bfhi(v.y); f[4] = bflo(v.z); f[5] = bfhi(v.z); f[6] = bflo(v.w); f[7] = bfhi(v.w); }
__device__ __forceinline__ u32x4 pack8(const float* f) { u32x4 v; v.x = pk2(f[0], f[1]); v.y = pk2(f[2], f[3]); v.z = pk2(f[4], f[5]); v.w = pk2(f[6], f[7]); return v; }

template <int KS> __device__ __forceinline__ void mma16(f32x4& acc, lbf_t X, int ldx, lbf_t Y, int ldy, int lane) {
    lbf_t xp = X + (lane & 15) * ldx + (lane >> 4) * 8;
    lbf_t yp = Y + (lane & 15) * ldy + (lane >> 4) * 8;
#pragma unroll
    for (int k = 0; k < KS; ++k) {
        const bf16x8 a = *(const LAS bf16x8*)(xp + k * 32);
        const bf16x8 b = *(const LAS bf16x8*)(yp + k * 32);
        acc = __builtin_amdgcn_mfma_f32_16x16x32_bf16(a, b, acc, 0, 0, 0);
    }
}

__device__ __forceinline__ void lds_sync() { asm volatile("s_waitcnt lgkmcnt(0)" ::: "memory"); __builtin_amdgcn_s_barrier(); asm volatile("" ::: "memory"); }
__device__ __forceinline__ int tsw(int row, int col) { return row * 72 + ((((col >> 3) ^ (row >> 3)) & 7) << 3) + (col & 7); }
template <int KS, bool XS, bool YS> __device__ __forceinline__ void mma16s(f32x4& acc, lbf_t X, int ldx, int xrow0, lbf_t Y, int ldy, int yrow0, int lane) {
    const int xr = xrow0 + (lane & 15), yr = yrow0 + (lane & 15), q4 = lane >> 4;
#pragma unroll
    for (int k = 0; k < KS; ++k) {
        const int c = k * 4 + q4;
        const bf16x8 a = *(const LAS bf16x8*)(X + xr * ldx + (XS ? ((c ^ (xr >> 3)) & 7) : c) * 8);
        const bf16x8 b = *(const LAS bf16x8*)(Y + yr * ldy + (YS ? ((c ^ (yr >> 3)) & 7) : c) * 8);
        acc = __builtin_amdgcn_mfma_f32_16x16x32_bf16(a, b, acc, 0, 0, 0);
    }
}

__device__ __forceinline__ bf16x8 ldf(lbf_t B, int ld, int row0, int kc, int lane) { return *(const LAS bf16x8*)(B + (row0 + (lane & 15)) * ld + (kc * 4 + (lane >> 4)) * 8); }
__device__ __forceinline__ bf16x8 ldfs(lbf_t B, int row0, int kc, int lane) { const int r = row0 + (lane & 15), c = kc * 4 + (lane >> 4); return *(const LAS bf16x8*)(B + r * 72 + ((c ^ (r >> 3)) & 7) * 8); }
#define MF(acc, a, b) acc = __builtin_amdgcn_mfma_f32_16x16x32_bf16(a, b, acc, 0, 0, 0)

template <bool GV = false> __device__ __forceinline__ void transpose_convert(const float* __restrict__ src, int K, int N, bf16_t* __restrict__ dst, int Npad, lds_t lds, int bid, int nb, int tid) {
    lf_t tl = (lf_t)lds;
    const int nTn = Npad / 128, ntiles = (K / 64) * nTn;
    f32x4 pv[4];
#define TC_LOAD(tile_) do { const int k0_ = ((tile_) / nTn) * 64, nt_ = (tile_) % nTn, n0_ = GV ? ((nt_ & 1) ? 2816 + (nt_ >> 1) * 128 : (nt_ >> 1) * 128) : nt_ * 128; _Pragma("unroll") for (int e = 0; e < 4; ++e) { const int kk = (tid >> 5) + e * 16, nn = (tid & 31) * 4; \
        pv[e] = (f32x4){0.f, 0.f, 0.f, 0.f}; if (n0_ + nn < N) pv[e] = __builtin_nontemporal_load((const f32x4*)(src + (size_t)(k0_ + kk) * N + n0_ + nn)); } } while (0)
    if (bid < ntiles) TC_LOAD(bid);
    for (int tile = bid; tile < ntiles; tile += nb) {
        const int k0 = (tile / nTn) * 64, n0 = (tile % nTn) * 128;
#pragma unroll
        for (int e = 0; e < 4; ++e) {
            const int kk = (tid >> 5) + e * 16, nn = (tid & 31) * 4; const f32x4 v = pv[e];
            tl[kk * 129 + nn] = v[0]; tl[kk * 129 + nn + 1] = v[1]; tl[kk * 129 + nn + 2] = v[2]; tl[kk * 129 + nn + 3] = v[3];
        }
        __syncthreads();
        if (tile + nb < ntiles) TC_LOAD(tile + nb);
#pragma unroll
        for (int e = 0; e < 2; ++e) { const int n = (tid >> 3) + e * 64, kc = (tid & 7) * 8; float f[8];
#pragma unroll
          for (int j = 0; j < 8; ++j) f[j] = tl[(kc + j) * 129 + n];
          *(u32x4*)(dst + (size_t)(n0 + n) * K + k0 + kc) = pack8(f); }
        __syncthreads();
    }
#undef TC_LOAD
}

__device__ __forceinline__ void phase_prep_b(const Params& P, lds_t lds, int bid, int nb, int tid) {
    unsigned char* ws = P.ws;
    transpose_convert(P.in[15], 1024, 6144, (bf16_t*)(ws + WS_WT_RET_IN), 6144, lds, bid, nb, tid);
    transpose_convert(P.in[16], 2048, 1024, (bf16_t*)(ws + WS_WT_RET_OUT), 1024, lds, bid, nb, tid);
    transpose_convert<true>(P.in[23], 1024, 5632, (bf16_t*)(ws + WS_WT_UP), 5632, lds, bid, nb, tid);
}
__device__ __forceinline__ void phase_prep_c(const Params& P, lds_t lds, int bid, int nb, int tid) {
    unsigned char* ws = P.ws;
    transpose_convert(P.in[17], 1024, 6176, (bf16_t*)(ws + WS_WT_GDN_IN), 6400, lds, bid, nb, tid);
    transpose_convert<true>(P.in[23] + (size_t)1024 * 5632, 1024, 5632, (bf16_t*)(ws + WS_WT_UP) + (size_t)5632 * 1024, 5632, lds, bid, nb, tid);
}
__device__ __forceinline__ void phase_prep_d(const Params& P, lds_t lds, int bid, int nb, int tid) {
    unsigned char* ws = P.ws;
    transpose_convert(P.in[26], 2816, 1024, (bf16_t*)(ws + WS_WT_DOWN), 1024, lds, bid, nb, tid);
    transpose_convert(P.in[22], 2048, 1024, (bf16_t*)(ws + WS_WT_GDN_OUT), 1024, lds, bid, nb, tid);
    transpose_convert(P.in[26] + (size_t)2816 * 1024, 2816, 1024, (bf16_t*)(ws + WS_WT_DOWN) + (size_t)1024 * 2816, 1024, lds, bid, nb, tid);
}
__device__ __forceinline__ void phase_prep(const Params& P, lds_t lds, int bid, int nb, int tid) {
    unsigned char* ws = P.ws;
    transpose_convert(P.in[8], 1024, 6144, (bf16_t*)(ws + WS_WT_ADA), 6144, lds, bid, nb, tid);
    transpose_convert(P.in[8] + (size_t)1024 * 6144, 1024, 6144, (bf16_t*)(ws + WS_WT_ADA) + (size_t)6144 * 1024, 6144, lds, bid, nb, tid);
    transpose_convert(P.in[10], 1024, 2048, (bf16_t*)(ws + WS_WT_ADA) + (size_t)12288 * 1024, 2048, lds, bid, nb, tid);
    const int gt = bid * 512 + tid, gs = nb * 512;
    bf16_t* cs = (bf16_t*)(ws + WS_CS);
    for (int i = gt; i < 256 * 1024; i += gs) {
        const int r = i >> 10, c = i & 1023; float v = 0.f;
        if (r < 8) v = silu_f(P.in[6][r * 1024 + c]); else if (r < 136) v = silu_f(P.in[7][(r - 8) * 1024 + c]);
        cs[i] = f2bf(v);
    }
    float* modb = (float*)(ws + WS_MODB);
    for (int i = gt; i < MODN; i += gs) modb[i] = i < 12288 ? P.in[9][i] : P.in[11][i - 12288];
    float* rc = (float*)(ws + WS_ROPE); float* rs = rc + 2052 * 128;
    for (int i = gt; i < 2052 * 128; i += gs) {
        const int p = i >> 7, j = i & 127; const double pos = p < 2048 ? (double)p : (double)(16384 + p - 2048);
        const double inv = exp2(-(double)j * (13.287712379549449 / 128.0));
        double s, c; sincos(pos * inv, &s, &c); rc[i] = (float)c; rs[i] = (float)s;
    }
}

__device__ __forceinline__ void phase_adaln(const Params& P, const float* xp, const float* xs, const float* gw, int sh_off, int sc_off, bf16_t* h, float* yp, float* ys, int bid, int nb, int tid) {
    const float* mod = (const float*)(P.ws + WS_MOD);
    const int lane = tid & 63, w = tid >> 6;
    for (int row2 = bid * 32 + w * 4; row2 < MT; row2 += nb * 32) {
    f32x4 vv[4][4];
#pragma unroll
    for (int rr = 0; rr < 4; ++rr) { const int row = row2 + rr; const float* x = row < MP ? xp + (size_t)row * 1024 : xs + (size_t)(row - MP) * 1024;
#pragma unroll
        for (int i = 0; i < 4; ++i) vv[rr][i] = *(const f32x4*)(x + i * 256 + lane * 4); }
#pragma unroll
    for (int rr = 0; rr < 4; ++rr) { const int row = row2 + rr;
        const int seq = row < MP ? (row >> 11) : 8 + ((row - MP) >> 2);
        f32x4 v[4]; float ss = 0.f;
#pragma unroll
        for (int i = 0; i < 4; ++i) { v[i] = vv[rr][i]; ss += v[i][0] * v[i][0] + v[i][1] * v[i][1] + v[i][2] * v[i][2] + v[i][3] * v[i][3]; }
#pragma unroll
        for (int o = 32; o >= 1; o >>= 1) ss += __shfl_xor(ss, o);
        const float r = rsqrtf(ss * (1.f / 1024.f) + EPS);
        const float* shp = mod + (size_t)seq * MODN + sh_off; const float* scp = mod + (size_t)seq * MODN + sc_off;
#pragma unroll
        for (int i = 0; i < 4; ++i) {
            const int c = i * 256 + lane * 4;
            const f32x4 g = *(const f32x4*)(gw + c), sh = *(const f32x4*)(shp + c), sc = *(const f32x4*)(scp + c);
            f32x4 o = v[i] * r * g * (sc + 1.f) + sh;
            if (h) { u32x2 pkd; pkd.x = pk2(o[0], o[1]); pkd.y = pk2(o[2], o[3]); *(u32x2*)(h + (size_t)row * 1024 + c) = pkd; }
            else { float* y = row < MP ? yp + (size_t)row * 1024 : ys + (size_t)(row - MP) * 1024; __builtin_nontemporal_store(o, (f32x4*)(y + c)); }
        }
    }
    }
}

struct EpiResid {
    static constexpr bool PERM = false, AFTER_DRAIN = false;
    const float* bp; const float* bs; float* out; const float* gate;
    __device__ __forceinline__ void operator()(const f32x4 (&acc)[2][2][4][2], const pg8::Unit& u, int wr, int wc, int fr, int fq) const {
        const int row0 = u.pm * 256 + wr * 64 + fr, col0 = u.pn * 256 + wc * 32 + 4 * fq;
        const int seq = (u.pm * 256) >> 11;
        const float* gp = gate + (size_t)seq * MODN + col0;
        f32x4 g[2][2];
#pragma unroll
        for (int bj = 0; bj < 2; ++bj)
#pragma unroll
            for (int n = 0; n < 2; ++n) g[bj][n] = *(const f32x4*)(gp + bj * 128 + n * 16);
#pragma unroll
        for (int ai = 0; ai < 2; ++ai) {
            f32x4 b[4][2][2];
#pragma unroll
            for (int m = 0; m < 4; ++m)
#pragma unroll
                for (int bj = 0; bj < 2; ++bj)
#pragma unroll
                    for (int n = 0; n < 2; ++n) b[m][bj][n] = *(const f32x4*)(bp + (size_t)(row0 + ai * 128 + m * 16) * 1024 + col0 + bj * 128 + n * 16);
#pragma unroll
            for (int m = 0; m < 4; ++m)
#pragma unroll
                for (int bj = 0; bj < 2; ++bj)
#pragma unroll
                    for (int n = 0; n < 2; ++n) *(f32x4*)(out + (size_t)(row0 + ai * 128 + m * 16) * 1024 + col0 + bj * 128 + n * 16) = b[m][bj][n] + g[bj][n] * acc[ai][bj][m][n];
        }
    }
};
__device__ __forceinline__ float dpp_ror1(float x) { return __int_as_float(__builtin_amdgcn_update_dpp(0, __float_as_int(x), 0x121, 0xf, 0xf, false)); }
__device__ __forceinline__ float dpp_ror2(float x) { return __int_as_float(__builtin_amdgcn_update_dpp(0, __float_as_int(x), 0x122, 0xf, 0xf, false)); }
struct EpiUp {
    static constexpr bool PERM = true, AFTER_DRAIN = false;
    bf16_t* U; float* fcp; float* fcs; bf16_t* act; float* sideg; float* sidev; const float* wdw; const float* bdw;
    __device__ __forceinline__ void operator()(const f32x4 (&acc)[2][2][4][2], const pg8::Unit& u, int wr, int wc, int fr, int fq) const {
        const int row0 = u.pm * 256 + wr * 64 + fr, f0 = u.pn * 128 + wc * 32 + 8 * fq;
        if (u.pm >= 64) {
            const int col0 = u.pn * 256 + wc * 32 + 8 * fq;
#pragma unroll
            for (int ai = 0; ai < 2; ++ai)
#pragma unroll
                for (int m = 0; m < 4; ++m) { const int row = row0 + ai * 128 + m * 16, rs = row - MP, t = rs & 3; float* cp = (t >= 2) ? fcs + (size_t)((rs >> 2) * 2 + (t - 2)) * 2816 : nullptr;
#pragma unroll
                    for (int bj = 0; bj < 2; ++bj) { const f32x4 v0 = acc[ai][bj][m][0], v1 = acc[ai][bj][m][1];
                        u32x4 w; w.x = pk2(v0[0], v0[1]); w.y = pk2(v0[2], v0[3]); w.z = pk2(v1[0], v1[1]); w.w = pk2(v1[2], v1[3]);
                        *(u32x4*)(U + (size_t)row * 5632 + col0 + bj * 128) = w;
                        if (cp && bj == 0) { *(f32x4*)(cp + f0) = v0; *(f32x4*)(cp + f0 + 4) = v1; } } }
            return;
        }
        float w0[8], w1[8], w2[8], bb[8];
#pragma unroll
        for (int k = 0; k < 8; ++k) { w0[k] = wdw[f0 + k]; w1[k] = wdw[2816 + f0 + k]; w2[k] = wdw[2 * 2816 + f0 + k]; bb[k] = bdw[f0 + k]; }
#pragma unroll
        for (int ai = 0; ai < 2; ++ai) {
            const int seg = u.pm * 4 + ai * 2 + wr;
#pragma unroll
            for (int m = 0; m < 4; ++m) {
                const int row = row0 + ai * 128 + m * 16, t = row & 2047;
                float g0[8], gp[8], vv[8], o[8];
#pragma unroll
                for (int k = 0; k < 8; ++k) { g0[k] = acc[ai][0][m][k >> 2][k & 3]; vv[k] = acc[ai][1][m][k >> 2][k & 3]; gp[k] = (m > 0) ? acc[ai][0][m > 0 ? m - 1 : 0][k >> 2][k & 3] : 0.f; }
#pragma unroll
                for (int k = 0; k < 8; ++k) {
                    const float a1 = dpp_ror1(g0[k]), b1 = dpp_ror1(gp[k]), a2 = dpp_ror2(g0[k]), b2 = dpp_ror2(gp[k]);
                    const float g1 = fr >= 1 ? a1 : b1, g2 = fr >= 2 ? a2 : b2;
                    o[k] = silu_f(w0[k] * g2 + w1[k] * g1 + w2[k] * g0[k] + bb[k]) * vv[k];
                }
                if (m > 0 || fr >= 2) *(u32x4*)(act + (size_t)row * 2816 + f0) = pack8(o);
                if (m == 0 && fr < 2) { float* sg = sideg + ((size_t)seg * 4 + fr) * 2816 + f0; float* sv = sidev + ((size_t)seg * 2 + fr) * 2816 + f0;
                    *(f32x4*)sg = acc[ai][0][0][0]; *(f32x4*)(sg + 4) = acc[ai][0][0][1]; *(f32x4*)sv = acc[ai][1][0][0]; *(f32x4*)(sv + 4) = acc[ai][1][0][1]; }
                if (m == 3 && fr >= 14) { float* sg = sideg + ((size_t)seg * 4 + 2 + (fr - 14)) * 2816 + f0; *(f32x4*)sg = acc[ai][0][3][0]; *(f32x4*)(sg + 4) = acc[ai][0][3][1]; }
                if (t >= 2046) { float* cp = fcp + (size_t)((row >> 11) * 2 + (t - 2046)) * 2816 + f0; *(f32x4*)cp = acc[ai][0][m][0]; *(f32x4*)(cp + 4) = acc[ai][0][m][1]; }
            }
        }
    }
};
struct EpiGdnIn {
    static constexpr bool PERM = true, AFTER_DRAIN = false;
    bf16_t* proj; float* ba; float* gcp; float* gcs;
    __device__ __forceinline__ void operator()(const f32x4 (&acc)[2][2][4][2], const pg8::Unit& u, int wr, int wc, int fr, int fq) const {
        const int row0 = u.pm * 256 + wr * 64 + fr, col0 = u.pn * 256 + wc * 32 + 8 * fq;
#pragma unroll
        for (int ai = 0; ai < 2; ++ai)
#pragma unroll
            for (int m = 0; m < 4; ++m) {
                const int row = row0 + ai * 128 + m * 16; float* cp = nullptr;
                if (row < MP) { const int t = row & 2047; if (t >= 2045) cp = gcp + (size_t)((row >> 11) * 3 + (t - 2045)) * 4096; }
                else { const int rs = row - MP, t = rs & 3; if (t >= 1) cp = gcs + (size_t)((rs >> 2) * 3 + (t - 1)) * 4096; }
#pragma unroll
                for (int bj = 0; bj < 2; ++bj) { const int c = col0 + bj * 128; const f32x4 v0 = acc[ai][bj][m][0], v1 = acc[ai][bj][m][1];
                    if (c < 6144) {
                        u32x4 w; w.x = pk2(v0[0], v0[1]); w.y = pk2(v0[2], v0[3]); w.z = pk2(v1[0], v1[1]); w.w = pk2(v1[2], v1[3]);
                        *(u32x4*)(proj + (size_t)row * 6144 + c) = w;
                        if (cp && c < 4096) { *(f32x4*)(cp + c) = v0; *(f32x4*)(cp + c + 4) = v1; }
                    } else if (c < 6176) { float* bp = ba + (size_t)row * 32 + (c - 6144); *(f32x4*)bp = v0; *(f32x4*)(bp + 4) = v1; } }
            }
    }
};

template <int K> __device__ __forceinline__ void resid_sample_pieces(const bf16_t* A, const bf16_t* Bt, const EpiResid& E, lds_t lds, int bid, int nb, int tid) {
    const int lane = tid & 63, w = tid >> 6, l16 = lane & 15, q4 = lane >> 4;
    constexpr int KS = K / 32 / 8;
    LAS f32x4* red = (LAS f32x4*)lds;
    for (int p = bid; p < 256; p += nb) {
        const int r0 = MP + (p >> 3) * 16, ng0 = (p & 7) * 128;
        const bf16_t* ap = A + (size_t)(r0 + l16) * K + w * (KS * 32) + q4 * 8; const bf16_t* bp = Bt + (size_t)(ng0 + l16) * K + w * (KS * 32) + q4 * 8;
        f32x4 acc[8];
#pragma unroll
        for (int cb = 0; cb < 8; ++cb) acc[cb] = (f32x4){0.f, 0.f, 0.f, 0.f};
#pragma unroll 4
        for (int ks = 0; ks < KS; ++ks) { const bf16x8 a = *(const bf16x8*)(ap + ks * 32);
#pragma unroll
            for (int cb = 0; cb < 8; ++cb) { const bf16x8 b = *(const bf16x8*)(bp + (size_t)cb * 16 * K + ks * 32); acc[cb] = __builtin_amdgcn_mfma_f32_16x16x32_bf16(b, a, acc[cb], 0, 0, 0); } }
#pragma unroll
        for (int cb = 0; cb < 8; ++cb) red[(w * 8 + cb) * 64 + lane] = acc[cb];
        __syncthreads();
        f32x4 t = red[(0 * 8 + w) * 64 + lane];
#pragma unroll
        for (int k = 1; k < 8; ++k) t += red[(k * 8 + w) * 64 + lane];
        const int row = r0 + l16, c = ng0 + w * 16 + 4 * q4, seq = 8 + ((row - MP) >> 2);
        const float* base = E.bs + (size_t)(row - MP) * 1024;
        *(f32x4*)(E.out + (size_t)row * 1024 + c) = *(const f32x4*)(base + c) + *(const f32x4*)(E.gate + (size_t)seq * MODN + c) * t;
        __syncthreads();
    }
}
struct EpiNull { static constexpr bool PERM = false, AFTER_DRAIN = false;
    float* sink;
    __device__ __forceinline__ void operator()(const f32x4 (&acc)[2][2][4][2], const pg8::Unit& u, int wr, int wc, int fr, int fq) const {
        float s = 0.f;
#pragma unroll
        for (int ai = 0; ai < 2; ++ai)
#pragma unroll
            for (int bj = 0; bj < 2; ++bj)
#pragma unroll
                for (int m = 0; m < 4; ++m)
#pragma unroll
                    for (int n = 0; n < 2; ++n) s += acc[ai][bj][m][n][0] + acc[ai][bj][m][n][1] + acc[ai][bj][m][n][2] + acc[ai][bj][m][n][3];
        if (s == 1.2345e30f) sink[0] = s;
    }
};
template <class Epi> __device__ __forceinline__ void run_gemm(lds_t lds, const bf16_t* A, const bf16_t* Bt, int M, int N, int K, const Epi& E, int bid, int nb) {
    pg8::Gemm g{A, Bt, M, N, K}; pg8::StaticOrder S; S.init(M, N, nb, bid);
    pg8::gemm_phase<Epi, pg8::StaticOrder, false>(lds, g, S, E, nullptr);
    __syncthreads();
}

__device__ __forceinline__ void phase_post_ret(const Params& P, int bid, int nb, int tid) {
    const bf16_t* oraw = (const bf16_t*)(P.ws + WS_ORAW); const bf16_t* proj = (const bf16_t*)(P.ws + WS_PROJ);
    const float* ssq = (const float*)(P.ws + WS_SSQ); bf16_t* og = (bf16_t*)(P.ws + WS_OG);
    for (int u = bid * 512 + tid; u < MT * 256; u += nb * 512) {
        const int row = u >> 8, col = (u & 255) * 8, h = col >> 9;
        const f32x4* sp = (const f32x4*)(ssq + (size_t)row * 64 + h * 16);
        const f32x4 s0 = sp[0], s1 = sp[1], s2 = sp[2], s3 = sp[3];
        const float ss = (s0[0] + s0[1] + s0[2] + s0[3]) + (s1[0] + s1[1] + s1[2] + s1[3]) + (s2[0] + s2[1] + s2[2] + s2[3]) + (s3[0] + s3[1] + s3[2] + s3[3]);
        const float r = rsqrtf(ss * (1.f / 512.f) + EPS);
        float o[8], g[8];
        unpack8(*(const u32x4*)(oraw + (size_t)row * 2048 + col), o); unpack8(*(const u32x4*)(proj + (size_t)row * 6144 + 4096 + col), g);
#pragma unroll
        for (int j = 0; j < 8; ++j) o[j] = o[j] * r * silu_f(g[j]);
        *(u32x4*)(og + (size_t)row * 2048 + col) = pack8(o);
    }
}
__device__ __forceinline__ void phase_act(const Params& P, int l, int bid, int nb, int tid) {
    const bf16_t* U = (const bf16_t*)(P.ws + WS_U); bf16_t* act = (bf16_t*)(P.ws + WS_ACT);
    const float* sideg = (const float*)(P.ws + WS_SIDEG); const float* sidev = (const float*)(P.ws + WS_SIDEV);
    const float* wdw = P.in[24] + (size_t)l * 3 * 2816; const float* bdw = P.in[25] + (size_t)l * 2816;
    for (int u = bid * 512 + tid; u < 256 * 2 * 352; u += nb * 512) {
        const int f = (u % 352) * 8, rr = (u / 352) & 1, seg = u / 704, row = seg * 64 + rr, t = row & 2047;
        float g0[8], g1[8], g2[8], vv[8], o[8];
        const float* sg = sideg + (size_t)seg * 4 * 2816 + f;
#pragma unroll
        for (int k = 0; k < 8; ++k) { g0[k] = sg[rr * 2816 + k]; vv[k] = sidev[((size_t)seg * 2 + rr) * 2816 + f + k]; g1[k] = 0.f; g2[k] = 0.f; }
        if (rr == 1) {
#pragma unroll
            for (int k = 0; k < 8; ++k) g1[k] = sg[k];
            if (t >= 2) {
#pragma unroll
                for (int k = 0; k < 8; ++k) g2[k] = sg[-4 * 2816 + 3 * 2816 + k]; }
        } else if (t >= 2) {
#pragma unroll
            for (int k = 0; k < 8; ++k) { g1[k] = sg[-4 * 2816 + 3 * 2816 + k]; g2[k] = sg[-4 * 2816 + 2 * 2816 + k]; }
        }
#pragma unroll
        for (int k = 0; k < 8; ++k) o[k] = silu_f(wdw[f + k] * g2[k] + wdw[2816 + f + k] * g1[k] + wdw[2 * 2816 + f + k] * g0[k] + bdw[f + k]) * vv[k];
        *(u32x4*)(act + (size_t)row * 2816 + f) = pack8(o);
    }
    for (int u = MP * 352 + bid * 512 + tid; u < MT * 352; u += nb * 512) {
        const int row = u / 352, f = (u - row * 352) * 8, uc = (f >> 7) * 256 + (f & 127);
        float g0[8], g1[8], g2[8], vv[8];
        const bf16_t* up = U + (size_t)row * 5632 + uc;
        unpack8(*(const u32x4*)up, g0); unpack8(*(const u32x4*)(up + 128), vv);
        {
            const int rs = row - MP, t = rs & 3, b = rs >> 2;
            const float* buf = P.in[5] + (size_t)((l * 128 + b) * 2) * 2816 + f;
            if (t >= 1) unpack8(*(const u32x4*)(up - 5632), g1); else { for (int j = 0; j < 8; ++j) g1[j] = buf[2816 + j]; }
            if (t >= 2) unpack8(*(const u32x4*)(up - 2 * 5632), g2); else { for (int j = 0; j < 8; ++j) g2[j] = buf[t * 2816 + j]; }
        }
        float o[8];
#pragma unroll
        for (int j = 0; j < 8; ++j) { const float cv = wdw[f + j] * g2[j] + wdw[2816 + f + j] * g1[j] + wdw[2 * 2816 + f + j] * g0[j] + bdw[f + j]; o[j] = silu_f(cv) * vv[j]; }
        *(u32x4*)(act + (size_t)row * 2816 + f) = pack8(o);
    }
}

__device__ __forceinline__ void ret_prompt_task(const Params& P, int task, lds_t lds, int tid) {
    asm volatile("" : "+v"(tid));
    const int ph = ((task >> 6) << 3) + (task & 7), sl = (task >> 3) & 7, b = ph >> 2, h = ph & 3;
    const int lane = tid & 63, w = tid >> 6, q4 = lane >> 4, l16 = lane & 15;
    const bf16_t* proj = (const bf16_t*)(P.ws + WS_PROJ);
    const float* ropec = (const float*)(P.ws + WS_ROPE); const float* ropes = ropec + 2052 * 128;
    bf16_t* oraw = (bf16_t*)(P.ws + WS_ORAW); float* ssq = (float*)(P.ws + WS_SSQ);
    lbf_t Qs = (lbf_t)lds, Ks = Qs + 64 * 264, KdT = Ks + 64 * 264, VT = KdT + 256 * 72, Ps = VT + 64 * 72, ST = Ps + 64 * 72;
    const float lg2 = log2f(1.0f - exp2f(-5.0f - (float)h));
    const float cd = exp2f(64.f * lg2);
    f32x4 Sacc[8];
#pragma unroll
    for (int i = 0; i < 8; ++i) Sacc[i] = (f32x4){0.f, 0.f, 0.f, 0.f};
    for (int i = tid; i < 64 * 264 / 2; i += 512) ((LAS unsigned*)ST)[i] = 0u;
    u32x4 rq1[2], rq2[2], rk1[2], rk2[2], rv; f32x4 rc[2][2], rs[2][2];
    const int vt = tid >> 3, vc8 = tid & 7;
#define RET_LOAD(n) do { _Pragma("unroll") for (int e = 0; e < 2; ++e) { const int u = tid + e * 512, t = u >> 4, c8 = u & 15; \
        const bf16_t* bp = proj + (size_t)(b * 2048 + (n) * 64 + t) * 6144 + h * 256 + c8 * 8; \
        rq1[e] = *(const u32x4*)bp; rq2[e] = *(const u32x4*)(bp + 128); rk1[e] = *(const u32x4*)(bp + 1024); rk2[e] = *(const u32x4*)(bp + 1024 + 128); \
        const float* cp = ropec + (size_t)((n) * 64 + t) * 128 + c8 * 8; const float* sp = ropes + (size_t)((n) * 64 + t) * 128 + c8 * 8; \
        rc[e][0] = *(const f32x4*)cp; rc[e][1] = *(const f32x4*)(cp + 4); rs[e][0] = *(const f32x4*)sp; rs[e][1] = *(const f32x4*)(sp + 4); } \
        rv = *(const u32x4*)(proj + (size_t)(b * 2048 + (n) * 64 + vt) * 6144 + 2048 + h * 512 + sl * 64 + vc8 * 8); } while (0)
    RET_LOAD(0);
    for (int n_ = 0; n_ < 32; ++n_) {
        int n = __builtin_amdgcn_readfirstlane(n_); asm volatile("" : "+s"(n));
#pragma unroll
        for (int e = 0; e < 2; ++e) {
            const int u = tid + e * 512, t = u >> 4, c8 = u & 15;
            float q1[8], q2[8], k1[8], k2[8], a[8], c[8];
            unpack8(rq1[e], q1); unpack8(rq2[e], q2); unpack8(rk1[e], k1); unpack8(rk2[e], k2);
            const float kd = exp2f((float)(63 - t) * lg2);
#pragma unroll
            for (int j = 0; j < 8; ++j) { const float co = rc[e][j >> 2][j & 3], si = rs[e][j >> 2][j & 3]; a[j] = q1[j] * co - q2[j] * si; c[j] = q1[j] * si + q2[j] * co; }
            *(LAS u32x4*)(Qs + t * 264 + c8 * 8) = pack8(a); *(LAS u32x4*)(Qs + t * 264 + 128 + c8 * 8) = pack8(c);
#pragma unroll
            for (int j = 0; j < 8; ++j) { const float co = rc[e][j >> 2][j & 3], si = rs[e][j >> 2][j & 3]; a[j] = (k1[j] * co - k2[j] * si) * 0.0625f; c[j] = (k1[j] * si + k2[j] * co) * 0.0625f; }
            *(LAS u32x4*)(Ks + t * 264 + c8 * 8) = pack8(a); *(LAS u32x4*)(Ks + t * 264 + 128 + c8 * 8) = pack8(c);
#pragma unroll
            for (int j = 0; j < 8; ++j) { KdT[tsw(c8 * 8 + j, t)] = f2bf(a[j] * kd); KdT[tsw(128 + c8 * 8 + j, t)] = f2bf(c[j] * kd); }
        }
        { const unsigned vw[4] = {rv.x, rv.y, rv.z, rv.w};
#pragma unroll
          for (int j = 0; j < 4; ++j) { VT[tsw(vc8 * 8 + 2 * j, vt)] = (bf16_t)(vw[j] & 0xffffu); VT[tsw(vc8 * 8 + 2 * j + 1, vt)] = (bf16_t)(vw[j] >> 16); } }
        lds_sync();
        if (n + 1 < 32) RET_LOAD(n + 1);
        bf16x8 qf[8];
#pragma unroll
        for (int k = 0; k < 8; ++k) qf[k] = ldf(Qs, 264, (w & 3) * 16, k, lane);
        { const int ib = w & 3, i = ib * 16 + l16;
#pragma unroll
          for (int jj = 0; jj < 2; ++jj) { const int jb = (w >> 2) * 2 + jj; f32x4 acc = (f32x4){0.f, 0.f, 0.f, 0.f};
              if (jb <= ib) {
#pragma unroll
                  for (int k = 0; k < 8; ++k) MF(acc, ldf(Ks, 264, jb * 16, k, lane), qf[k]); }
              const int j0 = jb * 16 + 4 * q4; float pv[4];
#pragma unroll
              for (int r = 0; r < 4; ++r) { const int j = j0 + r; pv[r] = (i >= j) ? acc[r] * exp2f((float)(i - j) * lg2) : 0.f; }
              u32x2 pkd; pkd.x = pk2(pv[0], pv[1]); pkd.y = pk2(pv[2], pv[3]); *(LAS u32x2*)(Ps + i * 72 + j0) = pkd; } }
        lds_sync();
        { const int ib = w & 3, i = ib * 16 + l16; const float qd = exp2f((float)(i + 1) * lg2); float ss = 0.f;
          const size_t row = (size_t)b * 2048 + n * 64 + i;
#pragma unroll
          for (int dd = 0; dd < 2; ++dd) { const int dvb = (w >> 2) * 2 + dd; f32x4 acc = (f32x4){0.f, 0.f, 0.f, 0.f};
#pragma unroll
              for (int k = 0; k < 8; ++k) MF(acc, ldf(ST, 264, dvb * 16, k, lane), qf[k]);
              acc = acc * qd;
#pragma unroll
              for (int k = 0; k < 2; ++k) MF(acc, ldfs(VT, dvb * 16, k, lane), ldf(Ps, 72, ib * 16, k, lane));
              ss += acc[0] * acc[0] + acc[1] * acc[1] + acc[2] * acc[2] + acc[3] * acc[3];
              u32x2 pkd; pkd.x = pk2(acc[0], acc[1]); pkd.y = pk2(acc[2], acc[3]);
              *(u32x2*)(oraw + row * 2048 + h * 512 + sl * 64 + dvb * 16 + 4 * q4) = pkd; }
          ss += __shfl_xor(ss, 16); ss += __shfl_xor(ss, 32);
          if (q4 == 0) ssq[row * 64 + h * 16 + sl * 2 + (w >> 2)] = ss; }
        { bf16x8 kf[2][2];
#pragma unroll
          for (int a = 0; a < 2; ++a)
#pragma unroll
              for (int k = 0; k < 2; ++k) kf[a][k] = ldfs(KdT, w * 32 + a * 16, k, lane);
#pragma unroll
          for (int d = 0; d < 4; ++d) { const bf16x8 v0 = ldfs(VT, d * 16, 0, lane), v1 = ldfs(VT, d * 16, 1, lane);
#pragma unroll
              for (int a = 0; a < 2; ++a) { Sacc[a * 4 + d] = Sacc[a * 4 + d] * cd; MF(Sacc[a * 4 + d], kf[a][0], v0); MF(Sacc[a * 4 + d], kf[a][1], v1); } } }
        lds_sync();
#pragma unroll
        for (int a = 0; a < 2; ++a)
#pragma unroll
            for (int d = 0; d < 4; ++d) { const f32x4 s = Sacc[a * 4 + d]; u32x2 pkd; pkd.x = pk2(s[0], s[1]); pkd.y = pk2(s[2], s[3]);
                *(LAS u32x2*)(ST + (d * 16 + l16) * 264 + w * 32 + a * 16 + 4 * q4) = pkd; }
    }
#undef RET_LOAD
    float* so = P.out + O_RETP + (size_t)(b * 4 + h) * 256 * 512 + sl * 64 + (size_t)(w * 32 + 4 * q4) * 512 + l16;
    asm volatile("" : "+v"(so));
#pragma unroll
    for (int a = 0; a < 2; ++a)
#pragma unroll
        for (int d = 0; d < 4; ++d)
#pragma unroll
            for (int r = 0; r < 4; ++r) so[(size_t)(a * 16 + r) * 512 + d * 16] = Sacc[a * 4 + d][r];
    lds_sync();
}

__device__ __forceinline__ void ret_sample_task(const Params& P, int task, lds_t lds, int tid) {
    asm volatile("" : "+v"(tid));
    const int b = task >> 4, h = (task >> 2) & 3, sl = task & 3;
    const bf16_t* proj = (const bf16_t*)(P.ws + WS_PROJ);
    const float* ropec = (const float*)(P.ws + WS_ROPE); const float* ropes = ropec + 2052 * 128;
    bf16_t* oraw = (bf16_t*)(P.ws + WS_ORAW); float* ssq = (float*)(P.ws + WS_SSQ);
    lf_t qs = (lf_t)lds, ks = qs + 1024, vs = ks + 1024, red = vs + 512, Am = red + 512, ssr = Am + 16, redp = ssr + 16;
    const float lg2 = log2f(1.0f - exp2f(-5.0f - (float)h));
    const size_t row0 = (size_t)MP + b * 4;
#pragma unroll
    for (int e = 0; e < 2; ++e) {
        const int u = tid + e * 512, mat = u >> 9, t = (u >> 7) & 3, j = u & 127;
        const bf16_t* bp = proj + (row0 + t) * 6144 + mat * 1024 + h * 256 + j;
        const float x1 = bf2f(bp[0]), x2 = bf2f(bp[128]);
        const float co = ropec[(2048 + t) * 128 + j], si = ropes[(2048 + t) * 128 + j];
        const float sc = mat ? 0.0625f : 1.f; lf_t dst = mat ? ks : qs;
        dst[t * 256 + j] = (x1 * co - x2 * si) * sc; dst[t * 256 + 128 + j] = (x1 * si + x2 * co) * sc;
    }
    { const int t = tid >> 7, c = tid & 127; vs[t * 128 + c] = bf2f(proj[(row0 + t) * 6144 + 2048 + h * 512 + sl * 128 + c]); }
    lds_sync();
    { const int p = tid >> 5, l32 = tid & 31, i = p >> 2, j = p & 3; float s = 0.f;
      for (int d = l32; d < 256; d += 32) s += qs[i * 256 + d] * ks[j * 256 + d];
#pragma unroll
      for (int o = 16; o >= 1; o >>= 1) s += __shfl_xor(s, o);
      if (l32 == 0) Am[p] = (i >= j) ? s * exp2f((float)(i - j) * lg2) : 0.f; }
    lds_sync();
    { const int c4 = tid & 31, dg = tid >> 5;
      const size_t sbase = ((size_t)(b * 4 + h) * 256) * 512 + sl * 128 + c4 * 4;
      const float* Sin = P.in[2] + sbase; float* Sout = P.out + O_RETS + sbase;
      f32x4 vp[4], pq[4];
#pragma unroll
      for (int j = 0; j < 4; ++j) { vp[j] = *(LAS f32x4*)(vs + j * 128 + c4 * 4) * exp2f((float)(3 - j) * lg2); pq[j] = (f32x4){0.f, 0.f, 0.f, 0.f}; }
      const float g4 = exp2f(4.f * lg2);
      f32x4 sv[16];
#pragma unroll
      for (int dd = 0; dd < 16; ++dd) sv[dd] = __builtin_nontemporal_load((const f32x4*)(Sin + (size_t)(dg * 16 + dd) * 512));
#pragma unroll
      for (int dd = 0; dd < 16; ++dd) { const int dk = dg * 16 + dd; const f32x4 s = sv[dd];
          f32x4 sn = s * g4;
#pragma unroll
          for (int i = 0; i < 4; ++i) { pq[i] += s * qs[i * 256 + dk]; sn += vp[i] * ks[i * 256 + dk]; }
          __builtin_nontemporal_store(sn, (f32x4*)(Sout + (size_t)dk * 512)); }
#pragma unroll
      for (int i = 0; i < 4; ++i) *(LAS f32x4*)(redp + (dg * 4 + i) * 128 + c4 * 4) = pq[i]; }
    lds_sync();
    { float s = 0.f;
#pragma unroll
      for (int g = 0; g < 16; ++g) s += redp[g * 512 + tid];
      red[tid] = s; }
    lds_sync();
    if (tid < 128) {
        const int dv = tid; float v[4];
#pragma unroll
        for (int j = 0; j < 4; ++j) v[j] = vs[j * 128 + dv];
#pragma unroll
        for (int i = 0; i < 4; ++i) { float o = exp2f((float)(i + 1) * lg2) * red[i * 128 + dv];
#pragma unroll
            for (int j = 0; j < 4; ++j) o += Am[i * 4 + j] * v[j];
            oraw[(row0 + i) * 2048 + h * 512 + sl * 128 + dv] = f2bf(o);
            float s2 = o * o;
#pragma unroll
            for (int of = 32; of >= 1; of >>= 1) s2 += __shfl_xor(s2, of);
            if ((tid & 63) == 0) ssr[(tid >> 6) * 4 + i] = s2; }
    }
    lds_sync();
    if (tid < 16) { const int i = tid >> 2, k = tid & 3; const int slot = (k == 0) ? sl : 4 + 3 * sl + (k - 1); ssq[(row0 + i) * 64 + h * 16 + slot] = (k == 0) ? ssr[i] + ssr[4 + i] : 0.f; }
    lds_sync();
}

__device__ __forceinline__ void phase_retention(const Params& P, lds_t lds, int bid, int nb, int tid) {
#ifndef SUBREP
#define SUBREP 0
#endif
    if (bid & 1) for (int t = bid; t < 2048; t += nb) ret_sample_task(P, t, lds, tid);
    for (int t = bid; t < 256; t += nb) ret_prompt_task(P, t, lds, tid);
    if (!(bid & 1)) for (int t = bid; t < 2048; t += nb) ret_sample_task(P, t, lds, tid);
}
#define XB_TMO      128
#define XB_XCNT(j)  (256  + 64 * (j))
#define XB_XSUB(j)  (1280 + 64 * (j))
#define XB_XGEN(j)  (2304 + 64 * (j))
#define XB_TOP      3328
#define XB_TOPGEN   3392
#define XCD_BAR_WORDS 3456
#define XB_SPIN_CAP (1u << 18)

__device__ __forceinline__ unsigned xb_ld(unsigned* p)              { return __hip_atomic_load(p, __ATOMIC_RELAXED, __HIP_MEMORY_SCOPE_AGENT); }
__device__ __forceinline__ unsigned xb_add(unsigned* p, unsigned v) { return __hip_atomic_fetch_add(p, v, __ATOMIC_RELAXED, __HIP_MEMORY_SCOPE_AGENT); }
__device__ __forceinline__ unsigned xb_xcc_id() { return (unsigned)__builtin_amdgcn_s_getreg((3 << 11) | 20) & 0xFu; }
#define XB_SPIN(cond, bar) do { unsigned _sp = 0; while (cond) { __builtin_amdgcn_s_sleep(1); \
    if ((++_sp & 255u) == 0u) { if (xb_ld(&(bar)[XB_TMO])) break; if (_sp > XB_SPIN_CAP) { atomicAdd(&(bar)[XB_TMO], 1u); break; } } } } while (0)

struct XcdBarrier {
    unsigned* bar; unsigned x;
    volatile LAS unsigned* st;
};

__device__ __forceinline__ XcdBarrier xcd_barrier_post(unsigned* bar, volatile LAS unsigned* st) {
    XcdBarrier b; b.bar = bar; b.x = xb_xcc_id(); b.st = st;
    if (threadIdx.x == 0) (void)xb_add(&bar[XB_XCNT(b.x)], 1u);
    return b;
}
__device__ __forceinline__ void xcd_barrier_complete(unsigned* bar, unsigned x, unsigned& nloc, unsigned& nx) {
    const unsigned G = gridDim.x * gridDim.y * gridDim.z;
    unsigned sum, cnt, mine, sp = 0u;
    for (;;) {
        sum = 0u; cnt = 0u; mine = 0u;
#pragma unroll
        for (unsigned j = 0; j < 16; ++j) { const unsigned c = xb_ld(&bar[XB_XCNT(j)]); sum += c; cnt += (c > 0u) ? 1u : 0u; mine = (j == x) ? c : mine; }
        if (sum == G) break;
        __builtin_amdgcn_s_sleep(1);
        if ((++sp & 255u) == 0u) { if (xb_ld(&bar[XB_TMO])) break; if (sp > XB_SPIN_CAP) { atomicAdd(&bar[XB_TMO], 1u); break; } }
    }
    nloc = mine > 0u ? mine : 1u; nx = cnt > 0u ? cnt : 1u;
}

__device__ __forceinline__ void xcd_barrier(const XcdBarrier& b) {
    asm volatile("s_waitcnt vmcnt(0)" ::: "memory");
    __syncthreads();
    if (threadIdx.x == 0) {
        unsigned* bar = b.bar;
        __builtin_amdgcn_s_waitcnt(0);
        unsigned nloc = b.st[0], nx = b.st[1];
        if (nloc == 0u) { xcd_barrier_complete(bar, b.x, nloc, nx); b.st[0] = nloc; b.st[1] = nx; }
        const unsigned old = xb_add(&bar[XB_XSUB(b.x)], 1u);
        const unsigned gen = old / nloc;
        if (old + 1u == (gen + 1u) * nloc) {
            __builtin_amdgcn_fence(__ATOMIC_RELEASE, "agent");
            asm volatile("s_waitcnt vmcnt(0)" ::: "memory");
            const unsigned og = xb_add(&bar[XB_TOP], 1u);
            const unsigned tg = og / nx;
            if (og + 1u == (tg + 1u) * nx) xb_add(&bar[XB_TOPGEN], 1u);
            else XB_SPIN(xb_ld(&bar[XB_TOPGEN]) == tg, bar);
            __builtin_amdgcn_fence(__ATOMIC_ACQUIRE, "agent");
            xb_add(&bar[XB_XGEN(b.x)], 1u);
            asm volatile("s_waitcnt vmcnt(0)" ::: "memory");
        } else {
            XB_SPIN(xb_ld(&bar[XB_XGEN(b.x)]) == gen, bar);
            __builtin_amdgcn_fence(__ATOMIC_ACQUIRE, "agent");
            asm volatile("s_waitcnt vmcnt(0)" ::: "memory");
        }
    }
    __syncthreads();
}


__device__ __forceinline__ float softplus_f(float x) { return x > 20.f ? x : log1pf(__expf(x)); }
__device__ __forceinline__ unsigned char* grec(const Params& P, int b, int hv, int n) { return P.ws + WS_R2 + (size_t)((b * 16 + hv) * 32 + n) * GREC; }
constexpr int R_W = 0, R_U = 16384, R_ATT = 32768, R_QG = 40960, R_KG = 57344, R_EGL = 73728;

struct GaPre { u32x4 xq[7], xv[7]; float a, bb; };
__device__ __forceinline__ void gdn_prep_load(const Params& P, int task, int tid, GaPre& R) {
    const int b = task >> 8, hk = (task >> 5) & 7, n = task & 31;
    const int lane = tid & 63, w = tid >> 6, mat = tid >> 8, rsg = (tid >> 4) & 15, cgp = tid & 15;
    const bf16_t* proj = (const bf16_t*)(P.ws + WS_PROJ); const float* ba = (const float*)(P.ws + WS_BA);
    const int colq = mat * 1024 + hk * 128 + cgp * 8, colv = 2048 + (hk * 2 + mat) * 128 + cgp * 8;
#pragma unroll
    for (int rr = 0; rr < 7; ++rr) { const int t = n * 64 + rsg * 4 - 3 + rr; const bf16_t* rp = proj + ((size_t)b * 2048 + (t >= 0 ? t : 0)) * 6144;
        R.xq[rr] = *(const u32x4*)(rp + colq); R.xv[rr] = *(const u32x4*)(rp + colv);
        if (t < 0) { R.xq[rr] = (u32x4){0u, 0u, 0u, 0u}; R.xv[rr] = (u32x4){0u, 0u, 0u, 0u}; } }
    R.a = 0.f; R.bb = 0.f;
    if (w < 2) { const size_t row = (size_t)b * 2048 + n * 64 + lane; R.a = ba[row * 32 + 16 + hk * 2 + w]; R.bb = ba[row * 32 + hk * 2 + w]; }
}
__device__ __forceinline__ void gdn_prep_task(const Params& P, int task, int next_task, lds_t lds, int tid, GaPre& R) {
    asm volatile("" : "+v"(tid));
    const int b_ = task >> 8, hk = (task >> 5) & 7, n = task & 31;
    const int lane = tid & 63, w = tid >> 6, q4 = lane >> 4, l16 = lane & 15;
    const bf16_t* proj = (const bf16_t*)(P.ws + WS_PROJ); const float* ba = (const float*)(P.ws + WS_BA);
    const float* wconv = P.in[18];
    lbf_t Qn = (lbf_t)lds, Kn = Qn + 64 * 136, KbgT = Kn + 64 * 136  , VbT = KbgT + 2 * 128 * 72  ;
    lf_t Lm = (lf_t)(lds + 108544)  , Gs = (lf_t)(lds + 108544 + 2 * 16384)  , Bs = Gs + 128;
    const size_t r0 = (size_t)b_ * 2048 + n * 64;
    if (w < 2) {
        const int hvg = hk * 2 + w;
        const float a = R.a, bb = R.bb;
        float g = -__expf(P.in[19][hvg]) * softplus_f(a + P.in[20][hvg]);
#pragma unroll
        for (int o = 1; o < 64; o <<= 1) { const float t = __shfl_up(g, o); if (lane >= o) g += t; }
        Gs[w * 64 + lane] = g; Bs[w * 64 + lane] = sigmoid_f(bb);
    }
    lds_sync();
    { int b = __builtin_amdgcn_readfirstlane(b_); asm volatile("" : "+s"(b)); const int mat = tid >> 8, rsg = (tid >> 4) & 15, cgp = tid & 15;
      {
        const int col = mat * 1024 + hk * 128 + cgp * 8; float x[7][8], wv[4][8];
#pragma unroll
        for (int i = 0; i < 4; ++i) { const f32x4 a0 = *(const f32x4*)(wconv + i * 4096 + col), a1 = *(const f32x4*)(wconv + i * 4096 + col + 4);
            wv[i][0] = a0[0]; wv[i][1] = a0[1]; wv[i][2] = a0[2]; wv[i][3] = a0[3]; wv[i][4] = a1[0]; wv[i][5] = a1[1]; wv[i][6] = a1[2]; wv[i][7] = a1[3]; }
#pragma unroll
        for (int rr = 0; rr < 7; ++rr) unpack8(R.xq[rr], x[rr]);
#pragma unroll
        for (int rr = 0; rr < 4; ++rr) {
            float o[8], ss = 0.f;
#pragma unroll
            for (int j = 0; j < 8; ++j) { const float cv = wv[0][j] * x[rr][j] + wv[1][j] * x[rr + 1][j] + wv[2][j] * x[rr + 2][j] + wv[3][j] * x[rr + 3][j]; o[j] = silu_f(cv); ss += o[j] * o[j]; }
            ss += __shfl_xor(ss, 1); ss += __shfl_xor(ss, 2); ss += __shfl_xor(ss, 4); ss += __shfl_xor(ss, 8);
            const float rn = rsqrtf(ss + EPS) * (mat == 0 ? 0.08838834764831845f : 1.f);
#pragma unroll
            for (int j = 0; j < 8; ++j) o[j] *= rn;
            const int r = rsg * 4 + rr;
            *(LAS u32x4*)((mat == 0 ? Qn : Kn) + r * 136 + cgp * 8) = pack8(o);
#pragma unroll
            for (int hv = 0; hv < 2; ++hv) {
                const float G = Gs[hv * 64 + r], Gl = Gs[hv * 64 + 63], be = Bs[hv * 64 + r];
                unsigned char* rec = grec(P, b, hk * 2 + hv, n); float y[8];
                if (mat == 0) { const float e = __expf(G);
#pragma unroll
                    for (int j = 0; j < 8; ++j) y[j] = o[j] * e;
                    *(u32x4*)(rec + R_QG + (r * 128 + cgp * 8) * 2) = pack8(y);
                } else { const float e = __expf(Gl - G), e2 = be * __expf(G);
#pragma unroll
                    for (int j = 0; j < 8; ++j) y[j] = o[j] * e;
                    *(u32x4*)(rec + R_KG + (r * 128 + cgp * 8) * 2) = pack8(y);
#pragma unroll
                    for (int j = 0; j < 8; ++j) KbgT[hv * 128 * 72 + tsw(cgp * 8 + j, r)] = f2bf(o[j] * e2);
                }
            }
        }
      }
      asm volatile("" ::: "memory"); __builtin_amdgcn_sched_barrier(0);
      {
        const int hv = mat, col = 2048 + (hk * 2 + hv) * 128 + cgp * 8; float x[7][8], wv[4][8];
#pragma unroll
        for (int i = 0; i < 4; ++i) { const f32x4 a0 = *(const f32x4*)(wconv + i * 4096 + col), a1 = *(const f32x4*)(wconv + i * 4096 + col + 4);
            wv[i][0] = a0[0]; wv[i][1] = a0[1]; wv[i][2] = a0[2]; wv[i][3] = a0[3]; wv[i][4] = a1[0]; wv[i][5] = a1[1]; wv[i][6] = a1[2]; wv[i][7] = a1[3]; }
#pragma unroll
        for (int rr = 0; rr < 7; ++rr) unpack8(R.xv[rr], x[rr]);
#pragma unroll
        for (int rr = 0; rr < 4; ++rr) { const int r = rsg * 4 + rr; const float be = Bs[hv * 64 + r];
#pragma unroll
            for (int j = 0; j < 8; ++j) { const float cv = wv[0][j] * x[rr][j] + wv[1][j] * x[rr + 1][j] + wv[2][j] * x[rr + 2][j] + wv[3][j] * x[rr + 3][j];
                VbT[hv * 128 * 72 + tsw(cgp * 8 + j, r)] = f2bf(silu_f(cv) * be); } }
      }
      if (tid < 2) *(float*)(grec(P, b, hk * 2 + tid, n) + R_EGL) = __expf(Gs[tid * 64 + 63]);
    }
    lds_sync();
    int b = __builtin_amdgcn_readfirstlane(b_); asm volatile("" : "+s"(b));
    if (w < 4) {
        const int ib = w;
        for (int jb = 0; jb <= ib; ++jb) { f32x4 acc = (f32x4){0.f, 0.f, 0.f, 0.f};
            mma16<4>(acc, Kn + ib * 16 * 136, 136, Kn + jb * 16 * 136, 136, lane);
#pragma unroll
            for (int hv = 0; hv < 2; ++hv) { const int j = jb * 16 + l16; const float Gj = Gs[hv * 64 + j];
#pragma unroll
                for (int r = 0; r < 4; ++r) { const int i = ib * 16 + 4 * q4 + r; Lm[hv * 4096 + i * 64 + j] = (i > j) ? acc[r] * Bs[hv * 64 + i] * __expf(Gs[hv * 64 + i] - Gj) : 0.f; } } }
    } else {
        const int ib = w - 4, i = ib * 16 + l16;
        for (int jb = 0; jb < 4; ++jb) { f32x4 acc = (f32x4){0.f, 0.f, 0.f, 0.f};
            if (jb <= ib) mma16<4>(acc, Kn + jb * 16 * 136, 136, Qn + ib * 16 * 136, 136, lane);
#pragma unroll
            for (int hv = 0; hv < 2; ++hv) { const float Gi = Gs[hv * 64 + i]; float y[4];
#pragma unroll
                for (int r = 0; r < 4; ++r) { const int j = jb * 16 + 4 * q4 + r; y[r] = (i >= j) ? acc[r] * __expf(Gi - Gs[hv * 64 + j]) : 0.f; }
                u32x2 pkd; pkd.x = pk2(y[0], y[1]); pkd.y = pk2(y[2], y[3]);
                *(u32x2*)(grec(P, b, hk * 2 + hv, n) + R_ATT + (i * 64 + jb * 16 + 4 * q4) * 2) = pkd; } }
    }
    lds_sync();
    if (next_task < 2048) gdn_prep_load(P, next_task, tid, R);
    if (w < 2) {
        lf_t L = Lm + w * 4096; lbf_t T = (lbf_t)(lds + 142336) + w * 64 * 72;
        lbf_t stg = (w == 0 ? Qn : Kn);
        lbf_t L21b = stg, T11T = stg + 32 * 40, T22n = stg + 2 * 32 * 40, RT = stg + 3 * 32 * 40;
        const int half = lane >> 5, c = lane & 31;
        lf_t Lh = L + half * (32 * 64 + 32);
        float t[32];
#pragma unroll
        for (int i = 0; i < 32; ++i) {
            float s0 = (i == c) ? 1.f : 0.f, s1 = 0.f;
#pragma unroll
            for (int j4 = 0; j4 < (i + 3) / 4; ++j4) { const f32x4 l = *(LAS f32x4*)(Lh + i * 64 + j4 * 4);
#pragma unroll
                for (int e = 0; e < 4; ++e) { const int j = j4 * 4 + e; if (j < i) { if (e & 1) s1 -= l[e] * t[j]; else s0 -= l[e] * t[j]; } } }
            t[i] = s0 + s1;
        }
        { const int i = lane >> 1, c0 = (lane & 1) * 16; float f[16];
#pragma unroll
          for (int v = 0; v < 4; ++v) { const f32x4 l = *(LAS f32x4*)(L + (32 + i) * 64 + c0 + v * 4); f[v * 4] = l[0]; f[v * 4 + 1] = l[1]; f[v * 4 + 2] = l[2]; f[v * 4 + 3] = l[3]; }
          *(LAS u32x4*)(L21b + i * 40 + c0) = pack8(f); *(LAS u32x4*)(L21b + i * 40 + c0 + 8) = pack8(f + 8);
          *(LAS u32x4*)(T + i * 72 + 32 + c0) = (u32x4){0u, 0u, 0u, 0u}; *(LAS u32x4*)(T + i * 72 + 32 + c0 + 8) = (u32x4){0u, 0u, 0u, 0u}; }
        if (half == 0) {
#pragma unroll
            for (int v = 0; v < 4; ++v) *(LAS u32x4*)(T11T + c * 40 + v * 8) = pack8(t + v * 8);
        }
#pragma unroll
        for (int i = 0; i < 32; ++i) { const bf16_t tb = f2bf(t[i]); T[(half * 32 + i) * 72 + half * 32 + c] = tb; if (half) T22n[i * 40 + c] = tb; }
#pragma unroll
        for (int ib = 0; ib < 2; ++ib)
#pragma unroll
            for (int cb = 0; cb < 2; ++cb) { f32x4 acc = (f32x4){0.f, 0.f, 0.f, 0.f};
                MF(acc, ldf(L21b, 40, ib * 16, 0, lane), ldf(T11T, 40, cb * 16, 0, lane));
                u32x2 pkd; pkd.x = pk2(acc[0], acc[1]); pkd.y = pk2(acc[2], acc[3]);
                *(LAS u32x2*)(RT + (cb * 16 + l16) * 40 + ib * 16 + 4 * q4) = pkd; }
#pragma unroll
        for (int ib = 0; ib < 2; ++ib)
#pragma unroll
            for (int cb = 0; cb < 2; ++cb) { f32x4 acc = (f32x4){0.f, 0.f, 0.f, 0.f};
                MF(acc, ldf(T22n, 40, ib * 16, 0, lane), ldf(RT, 40, cb * 16, 0, lane));
#pragma unroll
                for (int r = 0; r < 4; ++r) T[(32 + ib * 16 + 4 * q4 + r) * 72 + cb * 16 + l16] = f2bf(-acc[r]); }
    }
    lds_sync();
    { int b = __builtin_amdgcn_readfirstlane(b_); asm volatile("" : "+s"(b)); const int hv = w >> 2, kind = (w >> 1) & 1, half = w & 1;
      lbf_t X = (kind ? VbT : KbgT) + hv * 128 * 72; lbf_t T = (lbf_t)(lds + 142336) + hv * 64 * 72;
      unsigned char* rec = grec(P, b, hk * 2 + hv, n) + (kind ? R_U : R_W);
      bf16x8 tf[4][2];
#pragma unroll
      for (int ib = 0; ib < 4; ++ib) { tf[ib][0] = ldf(T, 72, ib * 16, 0, lane); tf[ib][1] = ldf(T, 72, ib * 16, 1, lane); }
#pragma unroll
      for (int db = 0; db < 4; ++db) { const bf16x8 x0 = ldfs(X, (half * 4 + db) * 16, 0, lane), x1 = ldfs(X, (half * 4 + db) * 16, 1, lane);
#pragma unroll
          for (int ib = 0; ib < 4; ++ib) { const int dkb = half * 4 + db; f32x4 acc = (f32x4){0.f, 0.f, 0.f, 0.f};
              MF(acc, x0, tf[ib][0]); MF(acc, x1, tf[ib][1]);
              u32x2 pkd; pkd.x = pk2(acc[0], acc[1]); pkd.y = pk2(acc[2], acc[3]);
              *(u32x2*)(rec + ((ib * 16 + l16) * 128 + dkb * 16 + 4 * q4) * 2) = pkd; } } }
    lds_sync();
}

__device__ __forceinline__ void gdn_scan_task(const Params& P, int task, lds_t lds, int tid) {
    asm volatile("" : "+v"(tid));
    const int b = task >> 4, hvg = task & 15;
    const int lane = tid & 63, w = tid >> 6, q4 = lane >> 4, l16 = lane & 15;
    const bf16_t* proj = (const bf16_t*)(P.ws + WS_PROJ); bf16_t* og = (bf16_t*)(P.ws + WS_OG);
    lbf_t Wl = (lbf_t)lds, Ul = Wl + 64 * 136, QGl = Ul + 64 * 136, ATl = QGl + 64 * 136, KgT = ATl + 64 * 72, ST = KgT + 128 * 72, VnT = ST + 128 * 136;
    lf_t Os = (lf_t)lds;
    f32x4 Sacc[8];
#pragma unroll
    for (int i = 0; i < 8; ++i) Sacc[i] = (f32x4){0.f, 0.f, 0.f, 0.f};
    for (int i = tid; i < 128 * 136 / 2; i += 512) ((LAS unsigned*)ST)[i] = 0u;
    u32x4 rw[2], ru[2], rq[2], rk[2], ra, rz[2]; float regl;
    const int nrow = tid >> 3, ncs = (tid & 7) * 16;
    const float* normw = P.in[21];
#define GB_LOAD(n) do { const unsigned char* rec = grec(P, b, hvg, (n)); \
        _Pragma("unroll") for (int e = 0; e < 2; ++e) { const int off = (tid + e * 512) * 16; rw[e] = *(const u32x4*)(rec + R_W + off); ru[e] = *(const u32x4*)(rec + R_U + off); \
            rq[e] = *(const u32x4*)(rec + R_QG + off); rk[e] = *(const u32x4*)(rec + R_KG + off); } \
        ra = *(const u32x4*)(rec + R_ATT + tid * 16); regl = *(const float*)(rec + R_EGL); \
        const bf16_t* zp = proj + ((size_t)b * 2048 + (n) * 64 + nrow) * 6144 + 4096 + hvg * 128 + ncs; rz[0] = *(const u32x4*)zp; rz[1] = *(const u32x4*)(zp + 8); } while (0)
    GB_LOAD(0);
    for (int n_ = 0; n_ < 32; ++n_) {
        int n = __builtin_amdgcn_readfirstlane(n_); asm volatile("" : "+s"(n));
        const float egl = regl; const u32x4 z0 = rz[0], z1 = rz[1];
#pragma unroll
        for (int e = 0; e < 2; ++e) { const int cidx = tid + e * 512, r = cidx >> 4, c8 = cidx & 15;
            *(LAS u32x4*)(Wl + r * 136 + c8 * 8) = rw[e]; *(LAS u32x4*)(Ul + r * 136 + c8 * 8) = ru[e]; *(LAS u32x4*)(QGl + r * 136 + c8 * 8) = rq[e];
            const unsigned kw[4] = {rk[e].x, rk[e].y, rk[e].z, rk[e].w};
#pragma unroll
            for (int j = 0; j < 4; ++j) { KgT[tsw(c8 * 8 + 2 * j, r)] = (bf16_t)(kw[j] & 0xffffu); KgT[tsw(c8 * 8 + 2 * j + 1, r)] = (bf16_t)(kw[j] >> 16); } }
        *(LAS u32x4*)(ATl + (tid >> 3) * 72 + (tid & 7) * 8) = ra;
        lds_sync();
        if (n + 1 < 32) GB_LOAD(n + 1);
        const int ib = w & 3;
        bf16x8 wf[4];
#pragma unroll
        for (int k = 0; k < 4; ++k) wf[k] = ldf(Wl, 136, ib * 16, k, lane);
#pragma unroll
        for (int dd = 0; dd < 4; ++dd) { const int dvb = (w >> 2) * 4 + dd; f32x4 acc = (f32x4){0.f, 0.f, 0.f, 0.f};
#pragma unroll
            for (int k = 0; k < 4; ++k) MF(acc, wf[k], ldf(ST, 136, dvb * 16, k, lane));
            float vn[4];
#pragma unroll
            for (int r = 0; r < 4; ++r) vn[r] = bf2f(Ul[(ib * 16 + 4 * q4 + r) * 136 + dvb * 16 + l16]) - acc[r];
            u32x2 pkd; pkd.x = pk2(vn[0], vn[1]); pkd.y = pk2(vn[2], vn[3]);
            *(LAS u32x2*)(VnT + (dvb * 16 + l16) * 72 + ib * 16 + 4 * q4) = pkd; }
        lds_sync();
        f32x4 oacc[4];
        { bf16x8 qf[4], af[2];
#pragma unroll
          for (int k = 0; k < 4; ++k) qf[k] = ldf(QGl, 136, ib * 16, k, lane);
#pragma unroll
          for (int k = 0; k < 2; ++k) af[k] = ldf(ATl, 72, ib * 16, k, lane);
#pragma unroll
          for (int dd = 0; dd < 4; ++dd) { const int dvb = (w >> 2) * 4 + dd; oacc[dd] = (f32x4){0.f, 0.f, 0.f, 0.f};
#pragma unroll
              for (int k = 0; k < 4; ++k) MF(oacc[dd], qf[k], ldf(ST, 136, dvb * 16, k, lane));
#pragma unroll
              for (int k = 0; k < 2; ++k) MF(oacc[dd], af[k], ldf(VnT, 72, dvb * 16, k, lane)); } }
        { const bf16x8 k0f = ldfs(KgT, w * 16, 0, lane), k1f = ldfs(KgT, w * 16, 1, lane);
#pragma unroll
          for (int d = 0; d < 8; ++d) { Sacc[d] = Sacc[d] * egl; MF(Sacc[d], k0f, ldf(VnT, 72, d * 16, 0, lane)); MF(Sacc[d], k1f, ldf(VnT, 72, d * 16, 1, lane)); } }
#pragma unroll
        for (int dd = 0; dd < 4; ++dd) { const int dvb = (w >> 2) * 4 + dd;
#pragma unroll
            for (int r = 0; r < 4; ++r) Os[(ib * 16 + 4 * q4 + r) * 132 + dvb * 16 + l16] = oacc[dd][r]; }
        lds_sync();
#pragma unroll
        for (int d = 0; d < 8; ++d) { const f32x4 s = Sacc[d]; u32x2 pkd; pkd.x = pk2(s[0], s[1]); pkd.y = pk2(s[2], s[3]);
            *(LAS u32x2*)(ST + (d * 16 + l16) * 136 + w * 16 + 4 * q4) = pkd; }
        { float o[16], zf[16], ss = 0.f;
#pragma unroll
          for (int j4 = 0; j4 < 4; ++j4) { const f32x4 v = *(LAS f32x4*)(Os + nrow * 132 + ncs + j4 * 4); o[j4 * 4] = v[0]; o[j4 * 4 + 1] = v[1]; o[j4 * 4 + 2] = v[2]; o[j4 * 4 + 3] = v[3]; }
#pragma unroll
          for (int j = 0; j < 16; ++j) ss += o[j] * o[j];
          ss += __shfl_xor(ss, 1); ss += __shfl_xor(ss, 2); ss += __shfl_xor(ss, 4);
          const float rn = rsqrtf(ss * (1.f / 128.f) + EPS);
          unpack8(z0, zf); unpack8(z1, zf + 8);
#pragma unroll
          for (int j = 0; j < 16; ++j) o[j] = o[j] * rn * normw[ncs + j] * silu_f(zf[j]);
          bf16_t* op = og + ((size_t)b * 2048 + n * 64 + nrow) * 2048 + hvg * 128 + ncs;
          *(u32x4*)op = pack8(o); *(u32x4*)(op + 8) = pack8(o + 8); }
        lds_sync();
    }
#undef GB_LOAD
    float* so = P.out + O_GDNP + (size_t)(b * 16 + hvg) * 128 * 128 + (size_t)(w * 16 + 4 * q4) * 128 + l16;
    asm volatile("" : "+v"(so));
#pragma unroll
    for (int d = 0; d < 8; ++d)
#pragma unroll
        for (int r = 0; r < 4; ++r) so[r * 128 + d * 16] = Sacc[d][r];
    lds_sync();
}

__device__ __forceinline__ void gdn_sample_task(const Params& P, int task, lds_t lds, int tid) {
    asm volatile("" : "+v"(tid));
    const int b = task >> 4, hvg = task & 15, hk = hvg >> 1;
    const int lane = tid & 63, w = tid >> 6;
    const bf16_t* proj = (const bf16_t*)(P.ws + WS_PROJ); const float* ba = (const float*)(P.ws + WS_BA); bf16_t* og = (bf16_t*)(P.ws + WS_OG);
    const float* wconv = P.in[18];
    lf_t qs = (lf_t)lds, ks = qs + 512, vs = ks + 512, us = vs + 512, wsm = us + 512, red = wsm + 512  , vn = red + 1024, on = vn + 512,
         kkd = on + 512, qkd = kkd + 16, Gs = qkd + 16, Bs = Gs + 4, redp = Bs + 4  ;
    const size_t row0 = (size_t)MP + b * 4;
#pragma unroll
    for (int mat = 0; mat < 3; ++mat) {
        const int t = (tid >> 7) & 3, c = tid & 127;
        const int col = mat == 0 ? hk * 128 + c : (mat == 1 ? 1024 + hk * 128 + c : 2048 + hvg * 128 + c);
        float cv = 0.f;
#pragma unroll
        for (int i = 0; i < 4; ++i) { const int r = t + i;
            const float x = r < 3 ? P.in[4][(size_t)(b * 3 + r) * 4096 + col] : bf2f(proj[(row0 + r - 3) * 6144 + col]);
            cv += wconv[i * 4096 + col] * x; }
        (mat == 0 ? qs : (mat == 1 ? ks : vs))[t * 128 + c] = silu_f(cv);
    }
    if (tid < 4) {
        const float a = ba[(row0 + tid) * 32 + 16 + hvg], bb = ba[(row0 + tid) * 32 + hvg];
        float g = -__expf(P.in[19][hvg]) * softplus_f(a + P.in[20][hvg]);
        float t1 = __shfl_up(g, 1); if (tid >= 1) g += t1;
        float t2 = __shfl_up(g, 2); if (tid >= 2) g += t2;
        Gs[tid] = g; Bs[tid] = sigmoid_f(bb); }
    lds_sync();
    { const int mat = w >> 2, t = w & 3; lf_t p = (mat ? ks : qs) + t * 128;
      const float a = p[lane], c = p[lane + 64]; float ss = a * a + c * c;
#pragma unroll
      for (int o = 32; o >= 1; o >>= 1) ss += __shfl_xor(ss, o);
      const float rn = rsqrtf(ss + EPS) * (mat == 0 ? 0.08838834764831845f : 1.f);
      p[lane] = a * rn; p[lane + 64] = c * rn; }
    lds_sync();
    { const int p = tid >> 4, l = tid & 15, kind = p >> 4, i = (p >> 2) & 3, j = p & 3; lf_t xa = (kind ? qs : ks) + i * 128; float s = 0.f;
      for (int c = l; c < 128; c += 16) s += xa[c] * ks[j * 128 + c];
      s += __shfl_xor(s, 8); s += __shfl_xor(s, 4); s += __shfl_xor(s, 2); s += __shfl_xor(s, 1);
      if (l == 0) (kind ? qkd : kkd)[i * 4 + j] = s; }
    lds_sync();
    if (tid < 128) { const int c = tid; float u[4], ww[4];
#pragma unroll
        for (int i = 0; i < 4; ++i) { float ru = vs[i * 128 + c] * Bs[i], rw = ks[i * 128 + c] * Bs[i] * __expf(Gs[i]);
#pragma unroll
            for (int j = 0; j < 4; ++j) if (j < i) { const float l = Bs[i] * kkd[i * 4 + j] * __expf(Gs[i] - Gs[j]); ru -= l * u[j]; rw -= l * ww[j]; }
            u[i] = ru; ww[i] = rw; us[i * 128 + c] = ru; wsm[i * 128 + c] = rw; } }
    lds_sync();
    const int c4 = tid & 31, dg = tid >> 5;
    const size_t sbase = ((size_t)(b * 16 + hvg) * 128 + dg * 8) * 128 + c4 * 4;
    f32x4 S[8];
    { const float* Sin = P.in[3] + sbase; f32x4 pw[4], pq[4];
#pragma unroll
      for (int i = 0; i < 4; ++i) { pw[i] = (f32x4){0.f, 0.f, 0.f, 0.f}; pq[i] = (f32x4){0.f, 0.f, 0.f, 0.f}; }
#pragma unroll
      for (int dd = 0; dd < 8; ++dd) S[dd] = __builtin_nontemporal_load((const f32x4*)(Sin + dd * 128));
#pragma unroll
      for (int dd = 0; dd < 8; ++dd) { const int dk = dg * 8 + dd;
#pragma unroll
          for (int i = 0; i < 4; ++i) { pw[i] += S[dd] * wsm[i * 128 + dk]; pq[i] += S[dd] * qs[i * 128 + dk]; } }
#pragma unroll
      for (int i = 0; i < 4; ++i) { *(LAS f32x4*)(redp + (dg * 8 + i) * 128 + c4 * 4) = pw[i]; *(LAS f32x4*)(redp + (dg * 8 + 4 + i) * 128 + c4 * 4) = pq[i]; } }
    lds_sync();
#pragma unroll
    for (int e = 0; e < 2; ++e) { const int idx = tid + e * 512; float s = 0.f;
#pragma unroll
        for (int g = 0; g < 16; ++g) s += redp[g * 1024 + idx];
        red[idx] = s; }
    lds_sync();
    if (tid < 128) { const int dv = tid; float v[4];
#pragma unroll
        for (int i = 0; i < 4; ++i) { v[i] = us[i * 128 + dv] - red[i * 128 + dv]; vn[i * 128 + dv] = v[i]; }
#pragma unroll
        for (int i = 0; i < 4; ++i) { float o = __expf(Gs[i]) * red[(4 + i) * 128 + dv];
#pragma unroll
            for (int j = 0; j < 4; ++j) if (j <= i) o += qkd[i * 4 + j] * __expf(Gs[i] - Gs[j]) * v[j];
            on[i * 128 + dv] = o; } }
    lds_sync();
    { float* Sout = P.out + O_GDNS + sbase; const float eg = __expf(Gs[3]); f32x4 vv[4];
#pragma unroll
      for (int j = 0; j < 4; ++j) vv[j] = *(LAS f32x4*)(vn + j * 128 + c4 * 4) * __expf(Gs[3] - Gs[j]);
#pragma unroll
      for (int dd = 0; dd < 8; ++dd) { const int dk = dg * 8 + dd; f32x4 sn = S[dd] * eg;
#pragma unroll
          for (int j = 0; j < 4; ++j) sn += vv[j] * ks[j * 128 + dk];
          __builtin_nontemporal_store(sn, (f32x4*)(Sout + dd * 128)); } }
    if (w < 4) { const int i = w; const float a = on[i * 128 + lane], c = on[i * 128 + lane + 64]; float ss = a * a + c * c;
#pragma unroll
        for (int o = 32; o >= 1; o >>= 1) ss += __shfl_xor(ss, o);
        const float rn = rsqrtf(ss * (1.f / 128.f) + EPS);
        const bf16_t* zp = proj + (row0 + i) * 6144 + 4096 + hvg * 128; bf16_t* op = og + (row0 + i) * 2048 + hvg * 128;
        op[lane] = f2bf(a * rn * P.in[21][lane] * silu_f(bf2f(zp[lane]))); op[lane + 64] = f2bf(c * rn * P.in[21][lane + 64] * silu_f(bf2f(zp[lane + 64]))); }
    lds_sync();
}

__device__ __forceinline__ void phase_gdn_prep(const Params& P, lds_t lds, int bid, int nb, int tid) {
    asm volatile("" : "+v"(tid));
    GaPre R;
    if (bid < 2048) gdn_prep_load(P, bid, tid, R);
    for (int t = bid; t < 2048; t += nb) gdn_prep_task(P, t, t + nb, lds, tid, R);
}
__device__ __forceinline__ void phase_gdn_scan(const Params& P, lds_t lds, int bid, int nb, int tid) {
    if (nb >= 256) {
        if (bid < 128) { for (int rep = 0; rep < ((SUBREP & 1) ? 2 : 1); ++rep) gdn_scan_task(P, bid, lds, tid); }
        else for (int rep = 0; rep < ((SUBREP & 2) ? 2 : 1); ++rep) for (int t = bid - 128; t < 2048; t += nb - 128) gdn_sample_task(P, t, lds, tid);
    } else {
        for (int t = bid; t < 128; t += nb) gdn_scan_task(P, t, lds, tid);
        for (int t = bid; t < 2048; t += nb) gdn_sample_task(P, t, lds, tid);
    }
}

#ifndef PHMASK
#define PHMASK 0x1fffffu
#endif
constexpr int NPH = 21;
__global__ void __launch_bounds__(512) fwd(Params P) {
    extern __shared__ __attribute__((aligned(16))) unsigned char lds_raw[];
    lds_t lds = (lds_t)lds_raw;
    cg::grid_group grid = cg::this_grid();
    const int bid = blockIdx.x, nb = gridDim.x, tid = threadIdx.x;
    unsigned char* ws = P.ws;
    const float* mod = (const float*)(ws + WS_MOD);
    bf16_t* H = (bf16_t*)(ws + WS_H); float* XA = (float*)(ws + WS_XA); float* XB = (float*)(ws + WS_XB);
    bf16_t* PROJ = (bf16_t*)(ws + WS_PROJ); bf16_t* OG = (bf16_t*)(ws + WS_OG);
    const int lo = P.ph_lo, hi = P.ph_hi;
    volatile LAS unsigned* xst = (volatile LAS unsigned*)(lds + LDS_BYTES - 16);
    if (tid < 4) xst[tid] = 0u;
    __syncthreads();
    const XcdBarrier xbar = xcd_barrier_post((unsigned*)(ws + WS_CTL), xst);
#define SEAM(k) if ((k) + 1 < hi) { xcd_barrier(xbar); }
    if (lo < 0) grid.sync();
#ifndef REPMASK
#define REPMASK 0u
#endif
    if (lo <= 0 && 0 < hi) { if constexpr ((PHMASK >> 0) & 1u) { phase_prep(P, lds, bid, nb, tid); } SEAM(0) }
    if (lo <= 1 && 1 < hi) { if constexpr ((PHMASK >> 1) & 1u) { { pg8::EpiF32 E{(float*)(ws + WS_MOD), MODN, (const float*)(ws + WS_MODB)}; if (nb >= 128) { if (bid < 56) run_gemm(lds, (const bf16_t*)(ws + WS_CS), (const bf16_t*)(ws + WS_WT_ADA), 256, MODN, 1024, E, bid, 56); else phase_prep_b(P, lds, bid - 56, nb - 56, tid); } else { run_gemm(lds, (const bf16_t*)(ws + WS_CS), (const bf16_t*)(ws + WS_WT_ADA), 256, MODN, 1024, E, bid, nb); phase_prep_b(P, lds, bid, nb, tid); } } } SEAM(1) }
    if (lo <= 2 && 2 < hi) { if constexpr ((PHMASK >> 2) & 1u) { phase_adaln(P, P.in[0], P.in[1], P.in[12], 0, 1024, H, nullptr, nullptr, bid, nb, tid); } SEAM(2) }
    if (lo <= 3 && 3 < hi) { if constexpr ((PHMASK >> 3) & 1u) { { pg8::EpiBf16<0> E{PROJ, 6144, nullptr, 0, 0}; run_gemm(lds, H, (const bf16_t*)(ws + WS_WT_RET_IN), MT, 6144, 1024, E, bid, nb); if (nb > 96) { if (bid >= 48) phase_prep_c(P, lds, bid - 48, nb - 48, tid); } else phase_prep_c(P, lds, bid, nb, tid); } } SEAM(3) }
    if (lo <= 4 && 4 < hi) { if constexpr ((PHMASK >> 4) & 1u) { phase_retention(P, lds, bid, nb, tid); } SEAM(4) }
    if (lo <= 5 && 5 < hi) { if constexpr ((PHMASK >> 5) & 1u) { phase_post_ret(P, bid, nb, tid); } SEAM(5) }
    if (lo <= 6 && 6 < hi) { if constexpr ((PHMASK >> 6) & 1u) { { EpiResid E{P.in[0], P.in[1], XA, mod + 2048}; if constexpr ((SUBREP & 64) != 0) { EpiNull EN{(float*)(ws + WS_CTL + 8192)}; run_gemm(lds, OG, (const bf16_t*)(ws + WS_WT_RET_OUT), MP, 1024, 2048, EN, bid, nb); } run_gemm(lds, OG, (const bf16_t*)(ws + WS_WT_RET_OUT), MP, 1024, 2048, E, bid, nb); resid_sample_pieces<2048>(OG, (const bf16_t*)(ws + WS_WT_RET_OUT), E, lds, bid, nb, tid); } } SEAM(6) }
    if (lo <= 7 && 7 < hi) { if constexpr ((PHMASK >> 7) & 1u) { phase_adaln(P, XA, XA + (size_t)MP * 1024, P.in[13], 3072, 4096, H, nullptr, nullptr, bid, nb, tid); } SEAM(7) }
    if (lo <= 8 && 8 < hi) { if constexpr ((PHMASK >> 8) & 1u) { { EpiUp E{(bf16_t*)(ws + WS_U), P.out + O_FCP, P.out + O_FCS, (bf16_t*)(ws + WS_ACT), (float*)(ws + WS_SIDEG), (float*)(ws + WS_SIDEV), P.in[24], P.in[25]}; run_gemm(lds, H, (const bf16_t*)(ws + WS_WT_UP), MT, 5632, 1024, E, bid, nb); if (nb > 200) { if (bid >= 172) phase_prep_d(P, lds, bid - 172, nb - 172, tid); } else phase_prep_d(P, lds, bid, nb, tid); } } SEAM(8) }
    if (lo <= 9 && 9 < hi) { if constexpr ((PHMASK >> 9) & 1u) { phase_act(P, 0, bid, nb, tid); } SEAM(9) }
    if (lo <= 10 && 10 < hi) { if constexpr ((PHMASK >> 10) & 1u) { { EpiResid E{XA, XA + (size_t)MP * 1024, XB, mod + 5120}; if constexpr ((SUBREP & 64) != 0) { EpiNull EN{(float*)(ws + WS_CTL + 8192)}; run_gemm(lds, (const bf16_t*)(ws + WS_ACT), (const bf16_t*)(ws + WS_WT_DOWN), MP, 1024, 2816, EN, bid, nb); } run_gemm(lds, (const bf16_t*)(ws + WS_ACT), (const bf16_t*)(ws + WS_WT_DOWN), MP, 1024, 2816, E, bid, nb); resid_sample_pieces<2816>((const bf16_t*)(ws + WS_ACT), (const bf16_t*)(ws + WS_WT_DOWN), E, lds, bid, nb, tid); } } SEAM(10) }
    if (lo <= 11 && 11 < hi) { if constexpr ((PHMASK >> 11) & 1u) { phase_adaln(P, XB, XB + (size_t)MP * 1024, P.in[12] + 1024, 6144, 6144 + 1024, H, nullptr, nullptr, bid, nb, tid); } SEAM(11) }
    if (lo <= 12 && 12 < hi) { if constexpr ((PHMASK >> 12) & 1u) { { EpiGdnIn E{PROJ, (float*)(ws + WS_BA), P.out + O_GCP, P.out + O_GCS}; run_gemm(lds, H, (const bf16_t*)(ws + WS_WT_GDN_IN), MT, 6400, 1024, E, bid, nb); } } SEAM(12) }
    if (lo <= 13 && 13 < hi) { if constexpr ((PHMASK >> 13) & 1u) { phase_gdn_prep(P, lds, bid, nb, tid); } SEAM(13) }
    if (lo <= 14 && 14 < hi) { if constexpr ((PHMASK >> 14) & 1u) { phase_gdn_scan(P, lds, bid, nb, tid); } SEAM(14) }
    if (lo <= 15 && 15 < hi) { if constexpr ((PHMASK >> 15) & 1u) { { EpiResid E{XB, XB + (size_t)MP * 1024, XA, mod + 6144 + 2048}; run_gemm(lds, OG, (const bf16_t*)(ws + WS_WT_GDN_OUT), MP, 1024, 2048, E, bid, nb); resid_sample_pieces<2048>(OG, (const bf16_t*)(ws + WS_WT_GDN_OUT), E, lds, bid, nb, tid); } } SEAM(15) }
    if (lo <= 16 && 16 < hi) { if constexpr ((PHMASK >> 16) & 1u) { phase_adaln(P, XA, XA + (size_t)MP * 1024, P.in[13] + 1024, 6144 + 3072, 6144 + 4096, H, nullptr, nullptr, bid, nb, tid); } SEAM(16) }
    if (lo <= 17 && 17 < hi) { if constexpr ((PHMASK >> 17) & 1u) { { EpiUp E{(bf16_t*)(ws + WS_U), P.out + O_FCP + (size_t)8 * 2 * 2816, P.out + O_FCS + (size_t)128 * 2 * 2816, (bf16_t*)(ws + WS_ACT), (float*)(ws + WS_SIDEG), (float*)(ws + WS_SIDEV), P.in[24] + (size_t)3 * 2816, P.in[25] + 2816}; run_gemm(lds, H, (const bf16_t*)(ws + WS_WT_UP) + (size_t)5632 * 1024, MT, 5632, 1024, E, bid, nb); } } SEAM(17) }
    if (lo <= 18 && 18 < hi) { if constexpr ((PHMASK >> 18) & 1u) { phase_act(P, 1, bid, nb, tid); } SEAM(18) }
    if (lo <= 19 && 19 < hi) { if constexpr ((PHMASK >> 19) & 1u) { { EpiResid E{XA, XA + (size_t)MP * 1024, XB, mod + 6144 + 5120}; run_gemm(lds, (const bf16_t*)(ws + WS_ACT), (const bf16_t*)(ws + WS_WT_DOWN) + (size_t)1024 * 2816, MP, 1024, 2816, E, bid, nb); resid_sample_pieces<2816>((const bf16_t*)(ws + WS_ACT), (const bf16_t*)(ws + WS_WT_DOWN) + (size_t)1024 * 2816, E, lds, bid, nb, tid); } } SEAM(19) }
    if (lo <= 20 && 20 < hi) { if constexpr ((PHMASK >> 20) & 1u) { phase_adaln(P, XB, XB + (size_t)MP * 1024, P.in[14], 12288, 12288 + 1024, nullptr, P.out + O_YP, P.out + O_YS, bid, nb, tid); } SEAM(20) }
}

#ifndef ONE_LAUNCH
#ifdef REPMASK_SET
#define ONE_LAUNCH 0
#else
#define ONE_LAUNCH 1
#endif
#endif
extern "C" void kernel_launch(void* const* d_in, const int* in_sizes, int n_in, void* d_out, int out_size, void* d_ws, size_t ws_size, hipStream_t stream) {
    static int grid_blocks = 0;
    if (!grid_blocks) {
        int dev = 0, cus = 0, per_cu = 0;
        hipGetDevice(&dev);
        hipDeviceGetAttribute(&cus, hipDeviceAttributeMultiprocessorCount, dev);
        hipFuncSetAttribute((const void*)fwd, hipFuncAttributeMaxDynamicSharedMemorySize, LDS_BYTES);
        hipOccupancyMaxActiveBlocksPerMultiprocessor(&per_cu, (const void*)fwd, 512, LDS_BYTES);
        if (per_cu < 1) { fprintf(stderr, "occupancy query says %d blocks per CU\n", per_cu); per_cu = 1; }
        grid_blocks = cus;
        if (ws_size < WS_END) fprintf(stderr, "workspace too small: %zu < %zu\n", ws_size, (size_t)WS_END);
    }
    Params p{};
    hipMemsetAsync((char*)d_ws + WS_CTL, 0, XCD_BAR_WORDS * 4, stream);
    for (int i = 0; i < 27; ++i) p.in[i] = (const float*)d_in[i];
    p.out = (float*)d_out; p.ws = (unsigned char*)d_ws;
#if ONE_LAUNCH
    p.ph_lo = 0; p.ph_hi = NPH;
#ifdef RT_REP
    p.rep = RT_REP;
#endif
    { void* args[] = {&p}; hipError_t e = hipLaunchCooperativeKernel((void*)fwd, dim3(grid_blocks), dim3(512), args, LDS_BYTES, stream);
      if (e != hipSuccess) fprintf(stderr, "cooperative launch failed: %s (grid %d)\n", hipGetErrorString(e), grid_blocks); }
#else
    for (int ph = 0; ph < NPH; ++ph) { p.ph_lo = ph; p.ph_hi = ph + 1; const int nrep = ((REPMASK >> ph) & 1u) ? 2 : 1;
        for (int r = 0; r < nrep; ++r) hipLaunchKernelGGL(fwd, dim3(grid_blocks), dim3(512), LDS_BYTES, stream, p); }
#endif
}
```
